# Optimizing an MI355X kernel written in HIP

```python
import math
import jax, jax.numpy as jnp
from jax import lax
import numpy as np

D_MODEL = 1024
BATCH = 8
SEQ = 2048
DEPTH = 2
DEC_BATCH = 128
DEC_SEQ = 1
PAST_LEN = 16384
PAGE_SIZE = 128

GROUP_W = D_MODEL // 4
D_MIX = 4 * GROUP_W
RET_HEADS = 4
RET_DH = GROUP_W // RET_HEADS
ML_HEADS = 4
ML_DH = GROUP_W // ML_HEADS
S5_CH = 16
S5_GROUPS = GROUP_W // S5_CH
S5_P = 64
MEM_LEN = 256
XA_HEADS = 4
XA_DH = GROUP_W // XA_HEADS
CHUNK = 128
ROPE_BASE = 10000.0
EPS = 1e-6
NEG_INF = -1e30
DT_MIN = 1e-3
DT_MAX = 1e-1
SPLIT_SIZES = (GROUP_W, GROUP_W, GROUP_W, GROUP_W,
               GROUP_W, GROUP_W, GROUP_W, GROUP_W, GROUP_W, ML_HEADS, ML_HEADS,
               GROUP_W, GROUP_W,
               GROUP_W, GROUP_W)
D_IN = sum(SPLIT_SIZES)
SPLIT_IDX = tuple(int(i) for i in np.cumsum(SPLIT_SIZES)[:-1])

kernel_name = "hybrid_ret_mlstm_s5_memxattn_step"


def _rms_norm(x, w):
    xf = x.astype(jnp.float32)
    y = xf * lax.rsqrt(jnp.mean(xf * xf, axis=-1, keepdims=True) + EPS)
    return (y * w.astype(jnp.float32)).astype(x.dtype)


def _head_norm(h, gain):
    mu = jnp.mean(h, axis=-1, keepdims=True)
    var = jnp.mean(jnp.square(h - mu), axis=-1, keepdims=True)
    y = (h - mu) * lax.rsqrt(var + EPS)
    return y.reshape(h.shape[0], h.shape[1], -1) * gain.astype(jnp.float32)


def _rope(x, pos):
    half = x.shape[-1] // 2
    inv = ROPE_BASE ** (-jnp.arange(half, dtype=jnp.float32) / half)
    ang = pos.astype(jnp.float32)[:, None] * inv[None, :]
    cos = jnp.cos(ang)[None, :, None, :]
    sin = jnp.sin(ang)[None, :, None, :]
    x1, x2 = x[..., :half], x[..., half:]
    return jnp.concatenate([x1 * cos - x2 * sin, x1 * sin + x2 * cos], axis=-1)


def _chunk_len(T):
    return CHUNK if T % CHUNK == 0 else T


def _to_chunks(t, nc, L):
    B, T, H, d = t.shape
    return t.reshape(B, nc, L, H, d).transpose(1, 0, 3, 2, 4)


def _from_chunks(h, B, T):
    nc, _, H, L, d = h.shape
    return h.transpose(1, 0, 3, 2, 4).reshape(B, T, H, d)


def _retention(q, k, v, s0):
    B, T, H, d = q.shape
    L = _chunk_len(T)
    nc = T // L
    lg = jnp.log1p(-jnp.power(2.0, -5.0 - jnp.arange(H, dtype=jnp.float32)))[:, None]
    idx = jnp.arange(L, dtype=jnp.float32)
    diff = idx[:, None] - idx[None, :]
    decay = jnp.where(diff >= 0, jnp.exp(lg[:, :, None] * jnp.maximum(diff, 0.0)), 0.0)
    q_decay = jnp.exp(lg * (idx + 1.0))[..., None]
    k_decay = jnp.exp(lg * (L - 1.0 - idx))[..., None]
    chunk_decay = jnp.exp(lg * L)[..., None]
    qc, kc, vc = (_to_chunks(t, nc, L) for t in (q, k, v))

    def step(s, inp):
        qi, ki, vi = inp
        inner = jnp.einsum('bhld,bhmd->bhlm', qi, ki) * decay
        o = (jnp.einsum('bhlm,bhme->bhle', inner, vi)
             + jnp.einsum('bhld,bhde->bhle', qi * q_decay, s))
        s = s * chunk_decay + jnp.einsum('bhld,bhle->bhde', ki * k_decay, vi)
        return s, o

    s, o = lax.scan(step, s0, (qc, kc, vc))
    return _from_chunks(o, B, T), s


def _mlstm(q, k, v, ig, lf, c0, n0, m0):
    B, T, H, d = q.shape
    L = _chunk_len(T)
    nc = T // L
    qc, kc, vc = (_to_chunks(t, nc, L) for t in (q, k, v))
    ic = ig.reshape(B, nc, L, H).transpose(1, 0, 3, 2)
    fc = lf.reshape(B, nc, L, H).transpose(1, 0, 3, 2)
    causal = jnp.tril(jnp.ones((L, L), dtype=bool))

    def step(carry, inp):
        c, n, m = carry
        qi, ki, vi, ii, fi = inp
        b = jnp.cumsum(fi, axis=-1)
        a = b + m[..., None]
        dlog = jnp.where(causal, b[..., :, None] - b[..., None, :] + ii[..., None, :], NEG_INF)
        mt = jnp.maximum(a, jnp.max(dlog, axis=-1))
        w_intra = jnp.exp(dlog - mt[..., None])
        w_state = jnp.exp(a - mt)
        s = jnp.einsum('bhld,bhmd->bhlm', qi, ki) * w_intra
        num = (jnp.einsum('bhlm,bhme->bhle', s, vi)
               + w_state[..., None] * jnp.einsum('bhed,bhld->bhle', c, qi))
        den = jnp.sum(s, axis=-1) + w_state * jnp.einsum('bhd,bhld->bhl', n, qi)
        h = num / jnp.maximum(jnp.abs(den), jnp.exp(-mt))[..., None]
        wl, wsl = w_intra[..., -1, :], w_state[..., -1]
        c = wsl[..., None, None] * c + jnp.einsum('bhm,bhme,bhmd->bhed', wl, vi, ki)
        n = wsl[..., None] * n + jnp.einsum('bhm,bhmd->bhd', wl, ki)
        return (c, n, mt[..., -1]), h

    (c, n, m), h = lax.scan(step, (c0, n0, m0), (qc, kc, vc, ic, fc))
    return _from_chunks(h, B, T), c, n, m


def _s5(u, x0_re, x0_im, a_re, a_im, log_dt, b_re, b_im, c_re, c_im, d_skip):
    f32 = jnp.float32
    a_re, a_im, b_re, b_im, c_re, c_im = (t.astype(f32) for t in (a_re, a_im, b_re, b_im, c_re, c_im))
    B, T, _ = u.shape
    ug = u.reshape(B, T, S5_GROUPS, S5_CH)
    dt = jnp.exp(log_dt.astype(f32))[:, None]
    mag = jnp.exp(a_re * dt)
    ab_re, ab_im = mag * jnp.cos(a_im * dt), mag * jnp.sin(a_im * dt)
    den = a_re * a_re + a_im * a_im
    nr, ni = ab_re - 1.0, ab_im
    f_re = (nr * a_re + ni * a_im) / den
    f_im = (ni * a_re - nr * a_im) / den
    bb_re = f_re[..., None] * b_re - f_im[..., None] * b_im
    bb_im = f_re[..., None] * b_im + f_im[..., None] * b_re
    bu_re = jnp.einsum('gpc,btgc->btgp', bb_re, ug)
    bu_im = jnp.einsum('gpc,btgc->btgp', bb_im, ug)
    x0_re, x0_im = x0_re.astype(f32), x0_im.astype(f32)
    bu_re = bu_re.at[:, 0].add(ab_re * x0_re - ab_im * x0_im)
    bu_im = bu_im.at[:, 0].add(ab_re * x0_im + ab_im * x0_re)
    A_re = jnp.broadcast_to(ab_re, bu_re.shape)
    A_im = jnp.broadcast_to(ab_im, bu_im.shape)

    def combine(e1, e2):
        a1r, a1i, b1r, b1i = e1
        a2r, a2i, b2r, b2i = e2
        return (a2r * a1r - a2i * a1i, a2r * a1i + a2i * a1r,
                a2r * b1r - a2i * b1i + b2r, a2r * b1i + a2i * b1r + b2i)

    _, _, xr, xi = lax.associative_scan(combine, (A_re, A_im, bu_re, bu_im), axis=1)
    y = jnp.einsum('gcp,btgp->btgc', c_re, xr) - jnp.einsum('gcp,btgp->btgc', c_im, xi)
    y = y.reshape(B, T, -1) + d_skip.astype(f32) * u
    return y, xr[:, -1], xi[:, -1]


def _mem_attend(q, mk, mv):
    s = jnp.einsum('bthd,bmhd->bhtm', q, mk) * (q.shape[-1] ** -0.5)
    p = jax.nn.softmax(s, axis=-1)
    return jnp.einsum('bhtm,bmhd->bthd', p, mv)


def _mixer_layer(x, pos, ret_s, ml_c, ml_n, ml_m, s5_re, s5_im, mem_k, mem_v,
                 norm_w, w_in, ret_gn, ml_b_i, ml_b_f, ml_gn,
                 s5_a_re, s5_a_im, s5_log_dt, s5_b_re, s5_b_im, s5_c_re, s5_c_im, s5_d, s5_w_glu,
                 w_out):
    f32 = jnp.float32
    B, T, _ = x.shape
    hn = _rms_norm(x, norm_w)
    proj = jnp.einsum('btd,de->bte', hn, w_in)
    (r_q, r_k, r_v, r_g, m_q, m_k, m_v, m_o, m_g, m_i, m_f,
     s_u, s_g, a_q, a_g) = jnp.split(proj, SPLIT_IDX, axis=-1)

    def heads(t, H):
        return t.astype(f32).reshape(B, T, H, -1)

    rq = _rope(heads(r_q, RET_HEADS), pos)
    rk = _rope(heads(r_k, RET_HEADS), pos) * (RET_DH ** -0.5)
    ro, ret_new = _retention(rq, rk, heads(r_v, RET_HEADS), ret_s.astype(f32))
    ret_out = _head_norm(ro, ret_gn) * jax.nn.silu(r_g.astype(f32))

    ig = m_i.astype(f32) + ml_b_i.astype(f32)
    lf = jax.nn.log_sigmoid(m_f.astype(f32) + ml_b_f.astype(f32))
    mh, c_new, n_new, m_new = _mlstm(heads(m_q, ML_HEADS), heads(m_k, ML_HEADS) * (ML_DH ** -0.5),
                                     heads(m_v, ML_HEADS), ig, lf,
                                     ml_c.astype(f32), ml_n.astype(f32), ml_m.astype(f32))
    mh = mh * jax.nn.sigmoid(heads(m_o, ML_HEADS))
    ml_out = _head_norm(mh, ml_gn) * jax.nn.silu(m_g.astype(f32))

    sy, s5r_new, s5i_new = _s5(s_u.astype(f32), s5_re, s5_im, s5_a_re, s5_a_im, s5_log_dt,
                               s5_b_re, s5_b_im, s5_c_re, s5_c_im, s5_d)
    sy = jax.nn.gelu(sy)
    sy = sy * jax.nn.sigmoid(jnp.einsum('btc,ce->bte', sy, s5_w_glu.astype(f32)))
    s5_out = sy * jax.nn.silu(s_g.astype(f32))

    xa = _mem_attend(heads(a_q, XA_HEADS), mem_k.astype(f32), mem_v.astype(f32)).reshape(B, T, -1)
    xa_out = xa * jax.nn.silu(a_g.astype(f32))

    mix = jnp.concatenate([ret_out, ml_out, s5_out, xa_out], axis=-1).astype(x.dtype)
    y = x + jnp.einsum('bte,ed->btd', mix, w_out)
    return y, ret_new, c_new, n_new, m_new, s5r_new, s5i_new


def setup_inputs(seed: int = 0) -> dict:
    key = jax.random.key(seed)
    ks = iter(jax.random.split(key, 40))
    f32 = jnp.float32
    G, P = S5_GROUPS, S5_P

    def nrm(shape, scale=1.0):
        return scale * jax.random.normal(next(ks), shape, f32)

    n_idx = jnp.arange(P, dtype=f32)
    inp = {}
    inp["x_prompt"] = nrm((BATCH, SEQ, D_MODEL))
    inp["x_sample"] = nrm((DEC_BATCH, DEC_SEQ, D_MODEL))
    inp["mem_prompt"] = nrm((BATCH, MEM_LEN, D_MODEL))
    inp["state_ret"] = nrm((DEPTH, DEC_BATCH, RET_HEADS, RET_DH, RET_DH), 0.3)
    inp["state_mlstm_c"] = nrm((DEPTH, DEC_BATCH, ML_HEADS, ML_DH, ML_DH), 0.3)
    inp["state_mlstm_n"] = nrm((DEPTH, DEC_BATCH, ML_HEADS, ML_DH), 0.3)
    inp["state_mlstm_m"] = jax.random.uniform(next(ks), (DEPTH, DEC_BATCH, ML_HEADS), f32, 0.0, 3.0)
    inp["state_s5_re"] = nrm((DEPTH, DEC_BATCH, G, P), 0.1)
    inp["state_s5_im"] = nrm((DEPTH, DEC_BATCH, G, P), 0.1)
    inp["cache_mem_k"] = nrm((DEPTH, DEC_BATCH, MEM_LEN, XA_HEADS, XA_DH))
    inp["cache_mem_v"] = nrm((DEPTH, DEC_BATCH, MEM_LEN, XA_HEADS, XA_DH))
    inp["norm_w"] = 1.0 + nrm((DEPTH, D_MODEL), 0.02)
    inp["w_in"] = nrm((DEPTH, D_MODEL, D_IN), D_MODEL ** -0.5)
    inp["ret_gn"] = 1.0 + nrm((DEPTH, GROUP_W), 0.02)
    inp["ml_b_i"] = nrm((DEPTH, ML_HEADS), 0.1)
    inp["ml_b_f"] = jnp.linspace(3.0, 6.0, ML_HEADS, dtype=f32) + nrm((DEPTH, ML_HEADS), 0.1)
    inp["ml_gn"] = 1.0 + nrm((DEPTH, GROUP_W), 0.02)
    inp["s5_a_re"] = -0.5 * jnp.exp(nrm((DEPTH, G, P), 0.01))
    inp["s5_a_im"] = jnp.pi * n_idx + nrm((DEPTH, G, P), 0.01)
    inp["s5_log_dt"] = jax.random.uniform(next(ks), (DEPTH, G), f32, math.log(DT_MIN), math.log(DT_MAX))
    inp["s5_b_re"] = nrm((DEPTH, G, P, S5_CH), (2 * S5_CH) ** -0.5)
    inp["s5_b_im"] = nrm((DEPTH, G, P, S5_CH), (2 * S5_CH) ** -0.5)
    inp["s5_c_re"] = nrm((DEPTH, G, S5_CH, P), P ** -0.5)
    inp["s5_c_im"] = nrm((DEPTH, G, S5_CH, P), P ** -0.5)
    inp["s5_d"] = nrm((DEPTH, GROUP_W))
    inp["s5_w_glu"] = nrm((DEPTH, GROUP_W, GROUP_W), GROUP_W ** -0.5)
    inp["w_mem_k"] = nrm((DEPTH, D_MODEL, GROUP_W), D_MODEL ** -0.5)
    inp["w_mem_v"] = nrm((DEPTH, D_MODEL, GROUP_W), D_MODEL ** -0.5)
    inp["w_out"] = nrm((DEPTH, D_MIX, D_MODEL), D_MIX ** -0.5)
    inp["final_norm_w"] = 1.0 + nrm((D_MODEL,), 0.02)
    return inp


def reference(x_prompt, x_sample, mem_prompt, state_ret, state_mlstm_c, state_mlstm_n, state_mlstm_m,
              state_s5_re, state_s5_im, cache_mem_k, cache_mem_v,
              norm_w, w_in, ret_gn, ml_b_i, ml_b_f, ml_gn,
              s5_a_re, s5_a_im, s5_log_dt, s5_b_re, s5_b_im, s5_c_re, s5_c_im, s5_d, s5_w_glu,
              w_mem_k, w_mem_v, w_out, final_norm_w):
    f32 = jnp.float32
    Bp, Tp, _ = x_prompt.shape
    Bs, Ts, _ = x_sample.shape
    pos_p = jnp.arange(Tp, dtype=jnp.int32)
    pos_s = PAST_LEN + jnp.arange(Ts, dtype=jnp.int32)
    z_ret = jnp.zeros((Bp,) + state_ret.shape[2:], f32)
    z_c = jnp.zeros((Bp,) + state_mlstm_c.shape[2:], f32)
    z_n = jnp.zeros((Bp,) + state_mlstm_n.shape[2:], f32)
    z_m = jnp.zeros((Bp,) + state_mlstm_m.shape[2:], f32)
    z_sr = jnp.zeros((Bp,) + state_s5_re.shape[2:], f32)
    z_si = jnp.zeros((Bp,) + state_s5_im.shape[2:], f32)

    hp, hs = x_prompt, x_sample
    st_p = [[] for _ in range(6)]
    st_s = [[] for _ in range(6)]
    mk_list, mv_list = [], []
    for l in range(DEPTH):
        w = (norm_w[l], w_in[l], ret_gn[l], ml_b_i[l], ml_b_f[l], ml_gn[l],
             s5_a_re[l], s5_a_im[l], s5_log_dt[l], s5_b_re[l], s5_b_im[l], s5_c_re[l], s5_c_im[l],
             s5_d[l], s5_w_glu[l], w_out[l])
        mk_p = jnp.einsum('bmd,de->bme', mem_prompt, w_mem_k[l]).reshape(Bp, -1, XA_HEADS, XA_DH)
        mv_p = jnp.einsum('bmd,de->bme', mem_prompt, w_mem_v[l]).reshape(Bp, -1, XA_HEADS, XA_DH)
        mk_list.append(mk_p)
        mv_list.append(mv_p)
        hp, *sp = _mixer_layer(hp, pos_p, z_ret, z_c, z_n, z_m, z_sr, z_si, mk_p, mv_p, *w)
        hs, *ss = _mixer_layer(hs, pos_s, state_ret[l], state_mlstm_c[l], state_mlstm_n[l],
                               state_mlstm_m[l], state_s5_re[l], state_s5_im[l],
                               cache_mem_k[l], cache_mem_v[l], *w)
        for i in range(6):
            st_p[i].append(sp[i])
            st_s[i].append(ss[i])

    y_prompt = _rms_norm(hp, final_norm_w)
    y_sample = _rms_norm(hs, final_norm_w)
    dts = (state_ret.dtype, state_mlstm_c.dtype, state_mlstm_n.dtype, state_mlstm_m.dtype,
           state_s5_re.dtype, state_s5_im.dtype)
    P_ = [jnp.stack(st_p[i]).astype(dts[i]) for i in range(6)]
    S_ = [jnp.stack(st_s[i]).astype(dts[i]) for i in range(6)]
    memk_p = jnp.stack(mk_list)
    memv_p = jnp.stack(mv_list)
    return (y_prompt, y_sample, P_[0], S_[0], P_[1], S_[1], P_[2], S_[2], P_[3], S_[3],
            P_[4], S_[4], P_[5], S_[5], memk_p, memv_p)
```

```cpp
#include <hip/hip_runtime.h>
#include <hip/hip_cooperative_groups.h>
#include <cstdio>
#include <cstdint>
namespace cg = cooperative_groups;

#define DI __device__ __forceinline__
#define LAS __attribute__((address_space(3)))
typedef unsigned short bf16_t;
typedef short bf16x8 __attribute__((ext_vector_type(8)));
typedef float f32x4 __attribute__((ext_vector_type(4)));
typedef float f32x2 __attribute__((ext_vector_type(2)));
typedef float f32x16 __attribute__((ext_vector_type(16)));
typedef unsigned u32x4 __attribute__((ext_vector_type(4)));
typedef unsigned u32x2 __attribute__((ext_vector_type(2)));
typedef __bf16 bfv2 __attribute__((ext_vector_type(2)));

constexpr int D = 1024, MP = 16384, MS = 128, MT = MP + MS, MPAD = 16640, NPROJ = 3584  , DIN = 3336;
constexpr int LDS_BYTES = 148480, LDS_CTL = 147456;
constexpr float EPS = 1e-6f;
constexpr size_t O_YP = 0, O_YS = 16777216, O_RETP = O_YS + 131072, O_RETS = O_RETP + 262144, O_MLCP = O_RETS + 4194304,
                 O_MLCS = O_MLCP + 262144, O_MLNP = O_MLCS + 4194304, O_MLNS = O_MLNP + 4096, O_MLMP = O_MLNS + 65536,
                 O_MLMS = O_MLMP + 64, O_S5RP = O_MLMS + 1024, O_S5RS = O_S5RP + 16384, O_S5IP = O_S5RS + 262144,
                 O_S5IS = O_S5IP + 16384, O_MEMK = O_S5IS + 262144, O_MEMV = O_MEMK + 1048576;
constexpr size_t W_CTL = 0, W_BAR = 4096, W_PCNT = 20480  , W_WINT = 32768, W_WOUTT = W_WINT + 2ull * NPROJ * 1024 * 2, W_WMEMT = W_WOUTT + 2ull * 1024 * 1024 * 2,
                 W_WGLUT = W_WMEMT + 1024ull * 1024 * 2, W_MEMB = W_WGLUT + 2ull * 256 * 256 * 2, W_ROPE = W_MEMB + 2048ull * 1024 * 2,
                 W_ABAR = W_ROPE + 2049ull * 32 * 2 * 4 + 256, W_BBF = W_ABAR + 2ull * 16 * 64 * 2 * 4, W_BBM = W_BBF + 2ull * 16 * 64 * 16 * 2 * 4,
                 W_CM = W_BBM + 2ull * 16 * 128 * 16 * 2, W_XN = W_CM + 2ull * 16 * 16 * 128 * 2, W_GATES = W_XN + (size_t)MPAD * 1024 * 2,
                 W_PROJ = W_GATES + (size_t)MT * 8 * 4, W_SY = W_PROJ + (size_t)MPAD * NPROJ * 2, W_MIX = W_SY + (size_t)MPAD * 256 * 2,
                 W_XB = W_MIX + (size_t)MPAD * 1024 * 2,
                 W_XB2 = W_XB + 16384ull * 4 * 4,
                 W_END = W_XB2 + 16384ull * 4 * 4;

struct Args { const float* in[30]; float* out; unsigned char* ws; int ph_lo, ph_hi; };
typedef const Args __attribute__((address_space(4))) CArgs;
enum { I_XP = 0, I_XS, I_MEM, I_SRET, I_SC, I_SN, I_SM, I_S5R, I_S5I, I_CK, I_CV, I_NW, I_WIN, I_RGN, I_BI, I_BF, I_MGN,
       I_ARE, I_AIM, I_LDT, I_BRE, I_BIM, I_CRE, I_CIM, I_S5D, I_WGLU, I_WMK, I_WMV, I_WOUT, I_FNW };

DI unsigned pk2(float lo, float hi) { f32x2 v = {lo, hi}; bfv2 r = __builtin_convertvector(v, bfv2); return __builtin_bit_cast(unsigned, r); }
DI bf16_t f2bf(float f) { return (bf16_t)(pk2(f, 0.f) & 0xffffu); }
DI float bf2f(bf16_t b) { return __uint_as_float(((unsigned)b) << 16); }
DI float bflo(unsigned w) { return __uint_as_float(w << 16); }
DI float bfhi(unsigned w) { return __uint_as_float(w & 0xffff0000u); }
DI float wave_sum(float v) { for (int o = 32; o > 0; o >>= 1) v += __shfl_xor(v, o); return v; }
DI float sigmoidf_(float x) { return 1.0f / (1.0f + __expf(-x)); }
DI float siluf_(float x) { return x / (1.0f + __expf(-x)); }
DI float gelu_tanh(float y) { const float z = 0.7978845608028654f * (y + 0.044715f * y * y * y); const float t = 1.0f - 2.0f / (1.0f + __expf(2.0f * z)); return 0.5f * y * (1.0f + t); }
DI float logsigf_(float x) { return fminf(x, 0.f) - log1pf(__expf(-fabsf(x))); }
DI f32x16 mfma32(bf16x8 a, bf16x8 b, f32x16 c) { return __builtin_amdgcn_mfma_f32_32x32x16_bf16(a, b, c, 0, 0, 0); }
DI f32x4 mfma16(bf16x8 a, bf16x8 b, f32x4 c) { return __builtin_amdgcn_mfma_f32_16x16x32_bf16(a, b, c, 0, 0, 0); }
DI void unpack8(u32x4 w, float (&f)[8]) { f[0] = bflo(w.x); f[1] = bfhi(w.x); f[2] = bflo(w.y); f[3] = bfhi(w.y); f[4] = bflo(w.z); f[5] = bfhi(w.z); f[6] = bflo(w.w); f[7] = bfhi(w.w); }
DI u32x4 pack8(const float (&f)[8]) { u32x4 w; w.x = pk2(f[0], f[1]); w.y = pk2(f[2], f[3]); w.z = pk2(f[4], f[5]); w.w = pk2(f[6], f[7]); return w; }
DI void wave_lds_fence() { asm volatile("" ::: "memory"); __builtin_amdgcn_wave_barrier(); asm volatile("s_waitcnt lgkmcnt(0)" ::: "memory"); }
DI void sincos_f(float a, float& s, float& c) {
    const float n = rintf(a * 0.15915494309189535f);
    float r = fmaf(-n, 6.2831854820251465f, a); r = fmaf(-n, -1.7484555e-7f, r);
    const float x = r * 0.25f, x2 = x * x;
    const float sp = x * (1.0f + x2 * (-1.6666667e-1f + x2 * (8.3333333e-3f + x2 * (-1.9841270e-4f + x2 * 2.7557319e-6f))));
    const float cp = 1.0f + x2 * (-0.5f + x2 * (4.1666667e-2f + x2 * (-1.3888889e-3f + x2 * (2.4801587e-5f + x2 * -2.7557319e-7f))));
    const float s2 = 2.0f * sp * cp, c2 = 1.0f - 2.0f * sp * sp;
    s = 2.0f * s2 * c2; c = 1.0f - 2.0f * s2 * s2;
}

namespace pg8 {
constexpr int BM = 256, BK = 64, HALF = 128, HTB = HALF * BK * 2, STAGE_BYTES = 8 * HTB, NXCD = 8, WGM = 8;
__host__ __device__ __forceinline__ int lds_byte(int r, int c) { const int st = (r >> 4) * 2 + (c >> 5), rr = r & 15, cc = c & 31, ob = rr * 64 + cc * 2; return st * 1024 + (ob ^ (((ob >> 9) & 1) << 5)); }
__host__ __device__ __forceinline__ void stage_rc(int b, int& R, int& C) { const int st = b / 1024, sb = b % 1024, swz = sb ^ (((sb >> 9) & 1) << 5); R = (st >> 1) * 16 + swz / 64; C = (st & 1) * 32 + (swz % 64) / 2; }
__host__ __device__ __forceinline__ int perm32(int rho) { const int n = rho >> 4, i = rho & 15; return 8 * (i >> 2) + 4 * n + (i & 3); }
struct Unit { int pm, pn; };
struct Gemm { const bf16_t* A; const bf16_t* Bt; int M, N, K; const unsigned* ready; unsigned need; int gate_pm; };
struct StaticOrder {
    int nM, nN, nwg, G, c, direct;
    __device__ void init(int M, int N, int G_, int c_) { nM = M / BM; nN = N / BM; nwg = nM * nN; G = G_; c = c_; direct = 0; }
    __device__ void init_single(int pm) { nM = nN = nwg = G = 1; c = pm; direct = 1; }
    __device__ bool next(int i, Unit& u) const {
        if (direct) { if (i) return false; u.pm = c; u.pn = 0; return true; }
        const long L = (long)i * G + c; if (L >= nwg) return false;
        int wgid = (int)L; { const int q = nwg / NXCD, r = nwg % NXCD, xcd = wgid % NXCD, off = wgid / NXCD; wgid = (xcd < r ? xcd * (q + 1) : r * (q + 1) + (xcd - r) * q) + off; }
        const int nig = WGM * nN, gid = wgid / nig, fm = gid * WGM, gsz = (nM - fm) < WGM ? (nM - fm) : WGM;
        u.pm = fm + ((wgid % nig) % gsz); u.pn = (wgid % nig) / gsz; return true;
    }
};
struct Epi {
    int mode; bf16_t* O; const bf16_t* SY; const bf16_t* PROJ; float* out; const float* src;
    float* xbuf; unsigned* pcnt; const float* nw; bf16_t* XNo;
    DI bool perm() const { return mode == 0 || mode == 2; }
    DI void fused(f32x4 (&acc)[2][2][4][2], const Unit& u, int wr, int wc, int fr, int fq, LAS unsigned char* lds, int wid, int lane) const {
        LAS float* P = (LAS float*)lds; LAS float* S = (LAS float*)(lds + 4096);
        const int rloc = wr * 64 + fr, col0 = u.pn * BM + wc * 32 + 4 * fq;
#pragma unroll
        for (int ai = 0; ai < 2; ++ai)
#pragma unroll
            for (int m = 0; m < 4; ++m) { const size_t o = (size_t)(u.pm * BM + rloc + ai * HALF + m * 16) * 1024 + col0; float ss = 0.f;
#pragma unroll
                for (int bj = 0; bj < 2; ++bj)
#pragma unroll
                    for (int n = 0; n < 2; ++n) { const f32x4 sv = *(const f32x4*)(src + o + bj * HALF + n * 16); const f32x4 x = acc[ai][bj][m][n] + sv; acc[ai][bj][m][n] = x;
                        ss += (x[0] * x[0] + x[1] * x[1]) + (x[2] * x[2] + x[3] * x[3]); }
                ss += __shfl_xor(ss, 16); ss += __shfl_xor(ss, 32);
                if (fq == 0) P[(rloc + ai * HALF + m * 16) * 4 + wc] = ss;
                if (m & 1) __builtin_amdgcn_sched_barrier(0); }
        asm volatile("s_waitcnt lgkmcnt(0)" ::: "memory"); __builtin_amdgcn_s_barrier(); asm volatile("" ::: "memory");
        const int row = wid * 32 + (lane & 31);
        if (lane < 32) { const float t = (P[row * 4] + P[row * 4 + 1]) + (P[row * 4 + 2] + P[row * 4 + 3]);
            __hip_atomic_store(xbuf + (size_t)(u.pm * BM + row) * 4 + u.pn, t, __ATOMIC_RELAXED, __HIP_MEMORY_SCOPE_AGENT); }
        asm volatile("s_waitcnt vmcnt(0)" ::: "memory");
        if (lane == 0) __hip_atomic_fetch_add(pcnt + 16 * u.pm, 1u, __ATOMIC_RELAXED, __HIP_MEMORY_SCOPE_AGENT);
        if (wid == 0) {
            unsigned sp = 0;
            while ((unsigned)__builtin_amdgcn_readfirstlane(__hip_atomic_load(pcnt + 16 * u.pm, __ATOMIC_RELAXED, __HIP_MEMORY_SCOPE_AGENT)) < 32u && ++sp < (1u << 22)) __builtin_amdgcn_s_sleep(2);
            __builtin_amdgcn_fence(__ATOMIC_ACQUIRE, "agent");
        }
        asm volatile("s_waitcnt vmcnt(0) lgkmcnt(0)" ::: "memory"); __builtin_amdgcn_s_barrier(); asm volatile("" ::: "memory");
        if (lane < 32) { const float* slot = xbuf + (size_t)(u.pm * BM + row) * 4; float q = 0.f;
#pragma unroll
            for (int t = 0; t < 4; ++t) q += __hip_atomic_load(slot + t, __ATOMIC_RELAXED, __HIP_MEMORY_SCOPE_AGENT);
            S[row] = rsqrtf(q * (1.0f / 1024.0f) + EPS); }
        asm volatile("s_waitcnt lgkmcnt(0)" ::: "memory"); __builtin_amdgcn_s_barrier(); asm volatile("" ::: "memory");
#pragma unroll
        for (int ai = 0; ai < 2; ++ai)
#pragma unroll
            for (int m = 0; m < 4; ++m) { const size_t o = (size_t)(u.pm * BM + rloc + ai * HALF + m * 16) * 1024 + col0; const float rs = S[rloc + ai * HALF + m * 16];
#pragma unroll
                for (int bj = 0; bj < 2; ++bj)
#pragma unroll
                    for (int n = 0; n < 2; ++n) { const f32x4 w4 = *(const f32x4*)(nw + col0 + bj * HALF + n * 16); const f32x4 y = acc[ai][bj][m][n] * rs * w4;
                        if (mode == 4) *(f32x4*)(out + o + bj * HALF + n * 16) = y;
                        else { *(f32x4*)(out + o + bj * HALF + n * 16) = acc[ai][bj][m][n]; u32x2 w; w.x = pk2(y[0], y[1]); w.y = pk2(y[2], y[3]); *(u32x2*)(XNo + o + bj * HALF + n * 16) = w; } } }
    }
    DI void operator()(const f32x4 (&acc)[2][2][4][2], const Unit& u, int wr, int wc, int fr, int fq) const {
        const int row0 = u.pm * BM + wr * 64 + fr;
        if (mode == 0) {
            const int col0 = u.pn * BM + wc * 32 + 8 * fq;
#pragma unroll
            for (int ai = 0; ai < 2; ++ai)
#pragma unroll
                for (int m = 0; m < 4; ++m) { bf16_t* rowp = O + (size_t)(row0 + ai * HALF + m * 16) * NPROJ + col0;
#pragma unroll
                    for (int bj = 0; bj < 2; ++bj) { const f32x4 v0 = acc[ai][bj][m][0], v1 = acc[ai][bj][m][1];
                        u32x4 w; w.x = pk2(v0[0], v0[1]); w.y = pk2(v0[2], v0[3]); w.z = pk2(v1[0], v1[1]); w.w = pk2(v1[2], v1[3]);
                        *(u32x4*)(rowp + bj * HALF) = w; } }
        } else if (mode == 2) {
            const int col0 = wc * 32 + 8 * fq;
#pragma unroll
            for (int ai = 0; ai < 2; ++ai)
#pragma unroll
                for (int m = 0; m < 4; ++m) { const size_t row = (size_t)(row0 + ai * HALF + m * 16);
#pragma unroll
                    for (int bj = 0; bj < 2; ++bj) { const int col = col0 + bj * HALF;
                        const u32x4 syw = *(const u32x4*)(SY + row * 256 + col), sgw = *(const u32x4*)(PROJ + row * NPROJ + 2560 + col);
                        float sy[8], sg[8], o[8]; unpack8(syw, sy); unpack8(sgw, sg);
                        const f32x4 v0 = acc[ai][bj][m][0], v1 = acc[ai][bj][m][1];
#pragma unroll
                        for (int j = 0; j < 4; ++j) { o[j] = sy[j] * sigmoidf_(v0[j]) * siluf_(sg[j]); o[4 + j] = sy[4 + j] * sigmoidf_(v1[j]) * siluf_(sg[4 + j]); }
                        *(u32x4*)(O + row * 1024 + 512 + col) = pack8(o); }
                    if (m & 1) __builtin_amdgcn_sched_barrier(0); }
        } else if (mode == 1) {
            float* C = out + ((u.pn & 1) ? O_MEMV : O_MEMK) + (size_t)(u.pn >> 1) * 524288;
            const int col0 = wc * 32 + 4 * fq;
#pragma unroll
            for (int ai = 0; ai < 2; ++ai)
#pragma unroll
                for (int m = 0; m < 4; ++m) { float* rowp = C + (size_t)(row0 + ai * HALF + m * 16) * 256 + col0;
#pragma unroll
                    for (int bj = 0; bj < 2; ++bj)
#pragma unroll
                        for (int n = 0; n < 2; ++n) *(f32x4*)(rowp + bj * HALF + n * 16) = acc[ai][bj][m][n]; }
        } else {
            const int col0 = u.pn * BM + wc * 32 + 4 * fq;
#pragma unroll
            for (int ai = 0; ai < 2; ++ai)
#pragma unroll
                for (int m = 0; m < 4; ++m) { const size_t o = (size_t)(row0 + ai * HALF + m * 16) * 1024 + col0;
#pragma unroll
                    for (int bj = 0; bj < 2; ++bj)
#pragma unroll
                        for (int n = 0; n < 2; ++n) { const f32x4 sv = *(const f32x4*)(src + o + bj * HALF + n * 16); *(f32x4*)(out + o + bj * HALF + n * 16) = sv + acc[ai][bj][m][n]; }
                    if (m & 1) __builtin_amdgcn_sched_barrier(0); }
        }
    }
};

DI void a_ready_wait(const Gemm& g, int wid) {
    if (wid == 0) { unsigned sp = 0;
        while ((unsigned)__builtin_amdgcn_readfirstlane(__hip_atomic_load(g.ready, __ATOMIC_RELAXED, __HIP_MEMORY_SCOPE_AGENT)) < g.need && ++sp < (1u << 22)) __builtin_amdgcn_s_sleep(2);
        __builtin_amdgcn_fence(__ATOMIC_ACQUIRE, "agent");
        asm volatile("s_waitcnt vmcnt(0)" ::: "memory"); }
    asm volatile("" ::: "memory"); __builtin_amdgcn_s_barrier(); asm volatile("" ::: "memory");
}
DI void gemm_phase(const int tid, LAS unsigned char* lds, const Gemm g, const StaticOrder& S, const Epi& E) {
    const int wid = __builtin_amdgcn_readfirstlane(tid >> 6), lane = tid & 63, wr = wid >> 2, wc = wid & 3, fr = lane & 15, fq = lane >> 4;
    const int K = g.K, nt = K / BK;
    unsigned voffA[2], voffB[2];
#pragma unroll
    for (int i = 0; i < 2; ++i) { int R, C; stage_rc(tid * 16 + i * 8192, R, C); const int Rb = E.perm() ? ((R & ~31) + perm32(R & 31)) : R;
        voffA[i] = (unsigned)(R * K + C) * 2u; voffB[i] = (unsigned)(Rb * K + C) * 2u; }
    const size_t kstep = (size_t)(BK * 2);
    const size_t hstep = (size_t)HALF * K * 2;
    const size_t tstep = 2 * hstep;
    const unsigned ldsw = (unsigned)wid * 1024u;
    const int aoff = lds_byte(wr * 64 + fr, fq * 8), boff = lds_byte(wc * 32 + fr, fq * 8);
#define PG8_SA(b, h) (((b) * 2 + (h)) * HTB)
#define PG8_SB(b, h) ((4 + (b) * 2 + (h)) * HTB)
#define PG8_STAGE(bufoff, gbase, voff) do { _Pragma("unroll") for (int _i = 0; _i < 2; ++_i) \
        __builtin_amdgcn_global_load_lds((const unsigned*)((const char*)(gbase) + (voff)[_i]), (LAS unsigned*)(lds + (bufoff) + ldsw + _i * 8192), 16, 0, 0); } while (0)
#define PG8_LDA(dst, b, h) do { _Pragma("unroll") for (int m = 0; m < 4; ++m) _Pragma("unroll") for (int k = 0; k < 2; ++k) dst[m][k] = *(const LAS bf16x8*)(lds + PG8_SA(b, h) + aoff + m * 2048 + k * 1024); } while (0)
#define PG8_LDB(dst, b, h) do { _Pragma("unroll") for (int n = 0; n < 2; ++n) _Pragma("unroll") for (int k = 0; k < 2; ++k) dst[n][k] = *(const LAS bf16x8*)(lds + PG8_SB(b, h) + boff + n * 2048 + k * 1024); } while (0)
#define PG8_MMA(ai, bj, At, Bt) do { __builtin_amdgcn_s_setprio(1); _Pragma("unroll") for (int m = 0; m < 4; ++m) _Pragma("unroll") for (int n = 0; n < 2; ++n) _Pragma("unroll") for (int k = 0; k < 2; ++k) \
        acc[ai][bj][m][n] = __builtin_amdgcn_mfma_f32_16x16x32_bf16(Bt[n][k], At[m][k], acc[ai][bj][m][n], 0, 0, 0); __builtin_amdgcn_s_setprio(0); } while (0)
#define PG8_WAIT_V(n) asm volatile("s_waitcnt vmcnt(" #n ")" ::: "memory")
#define PG8_WAIT_L(n) asm volatile("s_waitcnt lgkmcnt(" #n ")" ::: "memory")
#define PG8_BAR __builtin_amdgcn_s_barrier()
#define PG8_SCHED __builtin_amdgcn_sched_barrier(0)
    Unit cur, nxt; int ui = 0;
    if (!S.next(0, cur)) return;
    f32x4 acc[2][2][4][2];
#pragma unroll
    for (int a = 0; a < 2; ++a)
#pragma unroll
        for (int b = 0; b < 2; ++b)
#pragma unroll
            for (int m = 0; m < 4; ++m)
#pragma unroll
                for (int n = 0; n < 2; ++n) acc[a][b][m][n] = (f32x4){0.f, 0.f, 0.f, 0.f};
    bf16x8 At[4][2], B0[2][2], B1[2][2];
    const char* cA = (const char*)g.A + (size_t)cur.pm * tstep; const char* cB = (const char*)g.Bt + (size_t)cur.pn * tstep;
    if (g.ready && cur.pm == g.gate_pm) a_ready_wait(g, wid);
    PG8_STAGE(PG8_SB(0, 0), cB, voffB); PG8_STAGE(PG8_SA(0, 0), cA, voffA); PG8_STAGE(PG8_SB(0, 1), cB + hstep, voffB); PG8_STAGE(PG8_SA(0, 1), cA + hstep, voffA);
    if (wr == 1) PG8_BAR;
    PG8_WAIT_V(4); PG8_BAR;
    PG8_STAGE(PG8_SB(1, 0), cB + kstep, voffB); PG8_STAGE(PG8_SA(1, 0), cA + kstep, voffA); PG8_STAGE(PG8_SB(1, 1), cB + hstep + kstep, voffB);
    PG8_WAIT_V(6); PG8_BAR;
    for (;;) {
        const bool has_next = S.next(ui + 1, nxt);
        const char* nA = has_next ? (const char*)g.A + (size_t)nxt.pm * tstep : cA; const char* nB = has_next ? (const char*)g.Bt + (size_t)nxt.pn * tstep : cB;
        for (int t = 0; t < nt; t += 2) {
            const bool last = (t == nt - 2);
            const char* a1 = cA + (size_t)(t + 1) * kstep;
            const char* a2 = last ? nA : cA + (size_t)(t + 2) * kstep; const char* b2 = last ? nB : cB + (size_t)(t + 2) * kstep;
            const char* a3 = a2 + kstep; const char* b3 = b2 + kstep;
            if (last && has_next && g.ready && nxt.pm == g.gate_pm) a_ready_wait(g, wid);
            PG8_LDB(B0, 0, 0); PG8_SCHED; PG8_LDA(At, 0, 0); PG8_STAGE(PG8_SA(1, 1), a1 + hstep, voffA);
            PG8_WAIT_L(8); PG8_BAR; PG8_WAIT_L(0); PG8_MMA(0, 0, At, B0); PG8_BAR; PG8_SCHED;
            PG8_LDB(B1, 0, 1); PG8_STAGE(PG8_SB(0, 0), b2, voffB);
            PG8_BAR; PG8_WAIT_L(0); PG8_MMA(0, 1, At, B1); PG8_BAR;
            PG8_LDA(At, 0, 1); PG8_STAGE(PG8_SA(0, 0), a2, voffA);
            PG8_BAR; PG8_WAIT_L(0); PG8_MMA(1, 0, At, B0); PG8_BAR; PG8_SCHED;
            PG8_STAGE(PG8_SB(0, 1), b2 + hstep, voffB);
            PG8_WAIT_V(6); PG8_BAR; PG8_MMA(1, 1, At, B1); PG8_BAR;
            PG8_LDB(B0, 1, 0); PG8_SCHED; PG8_LDA(At, 1, 0); PG8_STAGE(PG8_SA(0, 1), a2 + hstep, voffA);
            PG8_WAIT_L(8); PG8_BAR; PG8_WAIT_L(0); PG8_MMA(0, 0, At, B0); PG8_BAR; PG8_SCHED;
            PG8_LDB(B1, 1, 1); PG8_STAGE(PG8_SB(1, 0), b3, voffB);
            PG8_BAR; PG8_WAIT_L(0); PG8_MMA(0, 1, At, B1); PG8_BAR;
            PG8_LDA(At, 1, 1); PG8_STAGE(PG8_SA(1, 0), a3, voffA);
            PG8_BAR; PG8_WAIT_L(0); PG8_MMA(1, 0, At, B0); PG8_BAR; PG8_SCHED;
            PG8_STAGE(PG8_SB(1, 1), b3 + hstep, voffB);
            PG8_WAIT_V(6); PG8_BAR; PG8_MMA(1, 1, At, B1); PG8_BAR;
        }
        if (E.mode < 4) E(acc, cur, wr, wc, fr, fq);
        if (!has_next) break;
#pragma unroll
        for (int a = 0; a < 2; ++a)
#pragma unroll
            for (int b = 0; b < 2; ++b)
#pragma unroll
                for (int m = 0; m < 4; ++m)
#pragma unroll
                    for (int n = 0; n < 2; ++n) acc[a][b][m][n] = (f32x4){0.f, 0.f, 0.f, 0.f};
        cur = nxt; cA = nA; cB = nB; ++ui;
    }
    PG8_WAIT_V(0);
    if (wr == 0) PG8_BAR;
    PG8_BAR;
    if (E.mode >= 4) E.fused(acc, cur, wr, wc, fr, fq, lds, wid, lane);
#undef PG8_SA
#undef PG8_SB
#undef PG8_STAGE
#undef PG8_LDA
#undef PG8_LDB
#undef PG8_MMA
#undef PG8_WAIT_V
#undef PG8_WAIT_L
#undef PG8_BAR
#undef PG8_SCHED
}
}

DI void transpose_tile(const int tid, const float* src, int ld_src, int col0, int k0, bf16_t* dst, int n0, int K, float* tile) {
#pragma unroll
    for (int i = 0; i < 8; ++i) { const int kk = i * 8 + (tid >> 6), nn = tid & 63; tile[kk * 65 + nn] = src[(size_t)(k0 + kk) * ld_src + col0 + nn]; }
    __syncthreads();
#pragma unroll
    for (int i = 0; i < 8; ++i) { const int nn = i * 8 + (tid >> 6), kk = tid & 63; dst[(size_t)(n0 + nn) * K + k0 + kk] = f2bf(tile[kk * 65 + nn]); }
    __syncthreads();
}

DI void prep_tile(const int tid, CArgs& a, int t, float* tile) {
    unsigned char* ws = a.ws;
    if (t < 1664) { const int l = t / 832, r = t % 832, kt = r / 52, nt = r % 52; const int n0 = nt * 64;
        transpose_tile(tid, a.in[I_WIN] + (size_t)l * 1024 * DIN, DIN, n0 + (n0 >= 2304 ? 8 : 0), kt * 64, (bf16_t*)(ws + W_WINT) + (size_t)l * NPROJ * 1024, n0, 1024, tile); }
    else if (t < 2176) { const int u = t - 1664, l = u / 256, r = u % 256, kt = r / 16, nt = r % 16;
        transpose_tile(tid, a.in[I_WOUT] + (size_t)l * 1024 * 1024, 1024, nt * 64, kt * 64, (bf16_t*)(ws + W_WOUTT) + (size_t)l * 1024 * 1024, nt * 64, 1024, tile); }
    else if (t < 2432) { const int u = t - 2176, lk = u / 64, r = u % 64, kt = r / 4, nt = r % 4; const int l = lk >> 1, kv = lk & 1;
        transpose_tile(tid, a.in[kv ? I_WMV : I_WMK] + (size_t)l * 1024 * 256, 256, nt * 64, kt * 64, (bf16_t*)(ws + W_WMEMT) + (size_t)lk * 256 * 1024, nt * 64, 1024, tile); }
    else { const int u = t - 2432, l = u / 16, r = u % 16, kt = r / 4, nt = r % 4;
        transpose_tile(tid, a.in[I_WGLU] + (size_t)l * 65536, 256, nt * 64, kt * 64, (bf16_t*)(ws + W_WGLUT) + (size_t)l * 65536, nt * 64, 256, tile); }
}
DI void prep_gate_rows(CArgs& a, int i0, int iend, int stride, int l) {
    for (int i = i0; i < iend; i += stride) { const int n = i >> 10, k = i & 1023;
        ((bf16_t*)(a.ws + W_WINT))[((size_t)l * NPROJ + 3328 + n) * 1024 + k] = n < 8 ? f2bf(a.in[I_WIN][((size_t)l * 1024 + k) * DIN + 2304 + n]) : (bf16_t)0; }
}
DI void prep_task(const int tid, CArgs& a, int k, unsigned char* sm) {
    if (k < 223) {
#pragma unroll 1
        for (int j = 3 * k; j < 3 * k + 3 && j < 668; ++j) prep_tile(tid, a, 832 + j, (float*)sm);
    } else prep_gate_rows(a, (k - 223) * 32768 + tid, (k - 222) * 32768, 512, 1);
}
DI void phase_prep(const int tid, CArgs& a, unsigned char* sm) {
    const int nb = gridDim.x, bid = blockIdx.x;
    unsigned char* ws = a.ws;
    float* tile = (float*)sm;
#pragma unroll 1
    for (int t = bid; t < 1360; t += nb) prep_tile(tid, a, t < 832 ? t : (t < 1088 ? 1664 + (t - 832) : (t < 1344 ? 2176 + (t - 1088) : 2432 + (t - 1344))), tile);
    prep_gate_rows(a, bid * 512 + tid, 256 * 1024, nb * 512, 0);
    { const f32x4* src = (const f32x4*)a.in[I_MEM]; u32x2* dst = (u32x2*)(ws + W_MEMB);
#pragma unroll 2
      for (int i = bid * 512 + tid; i < 2048 * 1024 / 4; i += nb * 512) { const f32x4 v = src[i]; u32x2 w; w.x = pk2(v[0], v[1]); w.y = pk2(v[2], v[3]); dst[i] = w; } }
    { float* rope = (float*)(ws + W_ROPE);
#pragma unroll 1
      for (int i = bid * 512 + tid; i < 2049 * 32; i += nb * 512) { const int pr = i >> 5, j = i & 31; const float pos = pr == 2048 ? 16384.0f : (float)pr;
          const float inv = exp2f(-(float)j * (13.287712379549449f / 32.0f)); float sn, cs; sincos_f(pos * inv, sn, cs); rope[2 * i] = cs; rope[2 * i + 1] = sn; } }
#pragma unroll 1
    for (int i = bid * 512 + tid; i < 2048; i += nb * 512) {
        const int lg = i >> 6, p = i & 63;
        const float dt = __expf(a.in[I_LDT][lg]), are = a.in[I_ARE][i], aim = a.in[I_AIM][i];
        const float xx = are * dt, yy = aim * dt, ex1 = expm1f(xx), ex = ex1 + 1.0f;
        float sn, cs, sh, chh; sincos_f(yy, sn, cs); sincos_f(0.5f * yy, sh, chh);
        const float abr = ex * cs, abi = ex * sn, den = are * are + aim * aim, nr = ex1 - 2.0f * ex * sh * sh, ni = abi;
        const float fr = (nr * are + ni * aim) / den, fi = (ni * are - nr * aim) / den;
        ((f32x2*)(ws + W_ABAR))[i] = (f32x2){abr, abi};
        f32x2* bbf = (f32x2*)(ws + W_BBF) + (size_t)i * 16; bf16_t* bbm = (bf16_t*)(ws + W_BBM) + (size_t)lg * 128 * 16; bf16_t* cm = (bf16_t*)(ws + W_CM) + (size_t)lg * 16 * 128;
#pragma unroll 1
        for (int cc = 0; cc < 16; ++cc) { const float bre = a.in[I_BRE][(size_t)i * 16 + cc], bim = a.in[I_BIM][(size_t)i * 16 + cc];
            const float br = fr * bre - fi * bim, bi = fr * bim + fi * bre;
            bbf[cc] = (f32x2){br, bi}; bbm[p * 16 + cc] = f2bf(br); bbm[(64 + p) * 16 + cc] = f2bf(bi); }
#pragma unroll 1
        for (int ch = 0; ch < 16; ++ch) { cm[ch * 128 + p] = f2bf(a.in[I_CRE][((size_t)lg * 16 + ch) * 64 + p]); cm[ch * 128 + 64 + p] = f2bf(-a.in[I_CIM][((size_t)lg * 16 + ch) * 64 + p]); }
    }
}

DI void norm_sample_rows(const int tid, CArgs& a, int layer, const float* xs) {
    const int wid = tid >> 6, lane = tid & 63, j = ((int)blockIdx.x - ((int)gridDim.x - 16)) * 8 + wid;
    if (j < 0 || j >= MS) return;
    const float* nw = a.in[I_NW] + layer * 1024; const float* src = xs + (size_t)j * 1024; bf16_t* dst = (bf16_t*)(a.ws + W_XN) + (size_t)(MP + j) * 1024;
    f32x4 x[4]; float ss = 0.f;
#pragma unroll
    for (int i = 0; i < 4; ++i) { x[i] = *(const f32x4*)(src + 256 * i + 4 * lane); ss += x[i][0] * x[i][0] + x[i][1] * x[i][1] + x[i][2] * x[i][2] + x[i][3] * x[i][3]; }
    ss = wave_sum(ss); const float rstd = rsqrtf(ss * (1.0f / 1024.0f) + EPS);
#pragma unroll
    for (int i = 0; i < 4; ++i) { const int d0 = 256 * i + 4 * lane; const f32x4 w = *(const f32x4*)(nw + d0);
        u32x2 o; o.x = pk2(x[i][0] * rstd * w[0], x[i][1] * rstd * w[1]); o.y = pk2(x[i][2] * rstd * w[2], x[i][3] * rstd * w[3]); *(u32x2*)(dst + d0) = o; }
}
DI void phase_norm(const int tid, CArgs& a, int layer, const float* xp, const float* xs, unsigned char* sm, bool prompt_rows = true) {
    const int wid = tid >> 6, lane = tid & 63;
    const float* nw = a.in[I_NW] + layer * 1024;
    bf16_t* XN = (bf16_t*)(a.ws + W_XN);
    if (prompt_rows) {
        f32x4 xn_[4];
        { const int row = blockIdx.x * 8 + wid; if (row < MP) {
#pragma unroll
            for (int i = 0; i < 4; ++i) xn_[i] = *(const f32x4*)(xp + (size_t)row * 1024 + 256 * i + 4 * lane); } }
        for (int row = blockIdx.x * 8 + wid; row < MP; row += gridDim.x * 8) {
            f32x4 x[4]; float ss = 0.f;
#pragma unroll
            for (int i = 0; i < 4; ++i) { x[i] = xn_[i]; ss += x[i][0] * x[i][0] + x[i][1] * x[i][1] + x[i][2] * x[i][2] + x[i][3] * x[i][3]; }
            { const int nrow = row + gridDim.x * 8; if (nrow < MP) {
#pragma unroll
                for (int i = 0; i < 4; ++i) xn_[i] = *(const f32x4*)(xp + (size_t)nrow * 1024 + 256 * i + 4 * lane); } }
            ss = wave_sum(ss);
            const float rstd = rsqrtf(ss * (1.0f / 1024.0f) + EPS);
#pragma unroll
            for (int i = 0; i < 4; ++i) { const int d0 = 256 * i + 4 * lane; const f32x4 w = *(const f32x4*)(nw + d0);
                u32x2 o; o.x = pk2(x[i][0] * rstd * w[0], x[i][1] * rstd * w[1]); o.y = pk2(x[i][2] * rstd * w[2], x[i][3] * rstd * w[3]); *(u32x2*)(XN + (size_t)row * 1024 + d0) = o; }
        }
    }
    norm_sample_rows(tid, a, layer, xs);
}
DI void phase_final_norm(const int tid, CArgs& a) {
    const int wid = tid >> 6, lane = tid & 63; const float* nw = a.in[I_FNW];
    f32x4 xn_[4];
    { const int row = blockIdx.x * 8 + wid; if (row < MT) {
#pragma unroll
        for (int i = 0; i < 4; ++i) xn_[i] = *(const f32x4*)(a.out + (size_t)row * 1024 + 256 * i + 4 * lane); } }
    for (int row = blockIdx.x * 8 + wid; row < MT; row += gridDim.x * 8) {
        float* p = a.out + (size_t)row * 1024; f32x4 x[4]; float ss = 0.f;
#pragma unroll
        for (int i = 0; i < 4; ++i) { x[i] = xn_[i]; ss += x[i][0] * x[i][0] + x[i][1] * x[i][1] + x[i][2] * x[i][2] + x[i][3] * x[i][3]; }
        { const int nrow = row + gridDim.x * 8; if (nrow < MT) {
#pragma unroll
            for (int i = 0; i < 4; ++i) xn_[i] = *(const f32x4*)(a.out + (size_t)nrow * 1024 + 256 * i + 4 * lane); } }
        ss = wave_sum(ss); const float rstd = rsqrtf(ss * (1.0f / 1024.0f) + EPS);
#pragma unroll
        for (int i = 0; i < 4; ++i) { const f32x4 w = *(const f32x4*)(nw + 256 * i + 4 * lane); *(f32x4*)(p + 256 * i + 4 * lane) = x[i] * rstd * w; }
    }
}

template <bool ML>
DI void seq_mixer(const int tid, CArgs& a, int layer, int b, int h, unsigned char* sm) {
    const int wid = tid >> 6, lane = tid & 63, r = lane & 31, hh = lane >> 5;
    bf16_t* Qs = (bf16_t*)(sm); bf16_t* Ks = (bf16_t*)(sm + 18432); bf16_t* Vt = (bf16_t*)(sm + 36864); bf16_t* Kwt = (bf16_t*)(sm + 54272);
    bf16_t* Ps = (bf16_t*)(sm + 71680); bf16_t* Tt = (bf16_t*)(sm + 106496);
    float* vecs = (float*)(sm + 124928);
    float* den = vecs + 1280; float* dst = den + 128; float* nvec = dst + 128; float* stat = nvec + 128;
    const bf16_t* proj = (const bf16_t*)(a.ws + W_PROJ); bf16_t* MIX = (bf16_t*)(a.ws + W_MIX);
    const float* rope = (const float*)(a.ws + W_ROPE);
    const int QOFF = (ML ? 1024 : 0) + h * 64, KOFF = QOFF + 256, VOFF = QOFF + 512, OOFF = 1792 + h * 64, GOFF = (ML ? 2048 : 768) + h * 64, MIXOFF = (ML ? 256 : 0) + h * 64;
    const float* gn = a.in[ML ? I_MGN : I_RGN] + layer * 256 + h * 64;
    const float lg2 = log2f(1.0f - exp2f(-5.0f - (float)h));
    const int lt = wid >> 1, et = wid & 1, l = 32 * lt + r;
    for (int i = tid; i < 64 * 72; i += 512) Tt[i] = 0;
    if (tid < 64) nvec[tid] = 0.f;
    if (!ML && tid < 128) { vecs[tid] = exp2f(lg2 * (float)(tid + 1)); vecs[512 + tid] = exp2f(lg2 * (float)(127 - tid)); }
    f32x16 accT;
#pragma unroll
    for (int i = 0; i < 16; ++i) accT[i] = 0.f;
    float mprev = 0.f; const float bi_ = ML ? a.in[I_BI][layer * 4 + h] : 0.f, bf_ = ML ? a.in[I_BF][layer * 4 + h] : 0.f;
    int cur = 0;
    const int pl = tid & 127, pd8 = tid >> 7, ql = tid >> 2, qc = tid & 3;
    f32x4 gnl[4];
#pragma unroll
    for (int q = 0; q < 4; ++q) gnl[q] = *(const f32x4*)(gn + 32 * et + 8 * q + 4 * hh);
    u32x4 nq1, nq2, nk1, nk2, nv1, nv2; f32x4 ncs[4]; float ng0 = 0.f, ng1 = 0.f, ng2 = 0.f, ng3 = 0.f;
    auto issue_chunk = [&](int cc) {
        const bf16_t* base = proj + (size_t)(b * 2048 + cc * 128 + pl) * NPROJ; const bf16_t* baseq = proj + (size_t)(b * 2048 + cc * 128 + ql) * NPROJ;
        nq1 = *(const u32x4*)(baseq + QOFF + 8 * qc); nq2 = *(const u32x4*)(baseq + QOFF + 32 + 8 * qc);
        nk1 = *(const u32x4*)(baseq + KOFF + 8 * qc); nk2 = *(const u32x4*)(baseq + KOFF + 32 + 8 * qc);
        nv1 = *(const u32x4*)(base + VOFF + 8 * pd8); nv2 = *(const u32x4*)(base + VOFF + 32 + 8 * pd8);
        if (!ML) { const float* cs = rope + ((size_t)(cc * 128 + ql) * 32 + 8 * qc) * 2;
#pragma unroll
            for (int q = 0; q < 4; ++q) ncs[q] = *(const f32x4*)(cs + 4 * q); }
        if (ML && wid == 5) { const bf16_t* gp = proj + (size_t)(b * 2048 + cc * 128 + 2 * lane) * NPROJ + 3328; ng0 = bf2f(gp[h]); ng1 = bf2f(gp[4 + h]); ng2 = bf2f(gp[NPROJ + h]); ng3 = bf2f(gp[NPROJ + 4 + h]); }
    };
    auto gate_scan = [&](int cc) {
        float* V = vecs + (cc & 1) * 640; const int l0 = 2 * lane;
        const float gi0 = ng0 + bi_, gf0 = ng1 + bf_, gi1 = ng2 + bi_, gf1 = ng3 + bf_;
        const float lf0 = logsigf_(gf0), lf1 = logsigf_(gf1);
        float sc = lf0 + lf1;
#pragma unroll
        for (int o = 1; o < 64; o <<= 1) { const float t = __shfl_up(sc, o); if (lane >= o) sc += t; }
        const float b0 = sc - lf1, b1 = sc, g0 = gi0 - b0, g1 = gi1 - b1;
        float mx = fmaxf(g0, g1);
#pragma unroll
        for (int o = 1; o < 64; o <<= 1) { const float t = __shfl_up(mx, o); if (lane >= o) mx = fmaxf(mx, t); }
        float pv = __shfl_up(mx, 1); if (lane == 0) pv = -3.0e38f;
        const float M0 = fmaxf(mprev, fmaxf(pv, g0)), M1 = fmaxf(mprev, mx);
        V[l0] = __expf(mprev - M0); V[l0 + 1] = __expf(mprev - M1);
        V[128 + l0] = __expf(-(b0 + M0)); V[128 + l0 + 1] = __expf(-(b1 + M1));
        V[256 + l0] = g0; V[256 + l0 + 1] = g1; V[384 + l0] = M0; V[384 + l0 + 1] = M1;
        const float M127 = __shfl(M1, 63), b127 = __shfl(b1, 63);
        V[512 + l0] = __expf(g0 - M127); V[512 + l0 + 1] = __expf(g1 - M127);
        mprev = b127 + M127;
    };
    issue_chunk(0);
    if (ML && wid == 5) gate_scan(0);
    for (int c = 0; c < 16; ++c) {
        const int tok0 = b * 2048 + c * 128;
        float* V = vecs + (ML ? (c & 1) * 640 : 0);
        float* wst = V; float* emt = V + 128; float* gvec = V + 256; float* Mvec = V + 384; float* wl = V + 512;
        u32x2 owr[4], gwr[4];
        { const bf16_t* rowp = proj + (size_t)(tok0 + 32 * lt + (lane >> 3)) * NPROJ + 32 * et + 4 * (lane & 7);
#pragma unroll
          for (int i = 0; i < 4; ++i) { owr[i] = ML ? *(const u32x2*)(rowp + (size_t)(8 * i) * NPROJ + OOFF) : (u32x2){0u, 0u}; gwr[i] = *(const u32x2*)(rowp + (size_t)(8 * i) * NPROJ + GOFF); } }
        bf16_t* stgC = Ks + wid * 1152;
        bf16_t* stgD = Ps + wid * 1152;
        if (ML && tid < 128) den[tid] = 0.f;
        {
            const int d8 = pd8;
            const u32x4 q1 = nq1, q2 = nq2, k1 = nk1, k2 = nk2, v1 = nv1, v2 = nv2;
            float qa[8], qb[8], ka[8], kb[8]; unpack8(q1, qa); unpack8(q2, qb); unpack8(k1, ka); unpack8(k2, kb);
            if (!ML) {
#pragma unroll
                for (int j = 0; j < 8; ++j) { const float co = ncs[j >> 1][(j & 1) * 2], si = ncs[j >> 1][(j & 1) * 2 + 1];
                    const float x1 = qa[j], x2 = qb[j]; qa[j] = x1 * co - x2 * si; qb[j] = x1 * si + x2 * co;
                    const float y1 = ka[j], y2 = kb[j]; ka[j] = y1 * co - y2 * si; kb[j] = y1 * si + y2 * co; }
            }
#pragma unroll
            for (int j = 0; j < 8; ++j) { ka[j] *= 0.125f; kb[j] *= 0.125f; }
            *(u32x4*)(Qs + ql * 72 + 8 * qc) = pack8(qa); *(u32x4*)(Qs + ql * 72 + 32 + 8 * qc) = pack8(qb);
            *(u32x4*)(Ks + ql * 72 + 8 * qc) = pack8(ka); *(u32x4*)(Ks + ql * 72 + 32 + 8 * qc) = pack8(kb);
            const unsigned vv1[4] = {v1.x, v1.y, v1.z, v1.w}, vv2[4] = {v2.x, v2.y, v2.z, v2.w};
#pragma unroll
            for (int j = 0; j < 4; ++j) {
                Vt[(8 * d8 + 2 * j) * 136 + pl] = (bf16_t)(vv1[j] & 0xffffu); Vt[(8 * d8 + 2 * j + 1) * 136 + pl] = (bf16_t)(vv1[j] >> 16);
                Vt[(32 + 8 * d8 + 2 * j) * 136 + pl] = (bf16_t)(vv2[j] & 0xffffu); Vt[(32 + 8 * d8 + 2 * j + 1) * 136 + pl] = (bf16_t)(vv2[j] >> 16); }
            if (c < 15) issue_chunk(c + 1);
        }
        __syncthreads();
        const float wsl = ML ? wst[127] : exp2f(lg2 * 128.0f);
        {
            const float Ml = ML ? Mvec[l] : 0.f; float dsum = 0.f;
#pragma unroll
            for (int mi = 0; mi < 2; ++mi) {
                const int mt = 2 * (wid & 1) + mi;
                if (mt <= lt) {
                    f32x16 acc;
#pragma unroll
                    for (int i = 0; i < 16; ++i) acc[i] = 0.f;
#pragma unroll
                    for (int ks = 0; ks < 4; ++ks) { const bf16x8 af = *(const bf16x8*)(Ks + (32 * mt + r) * 72 + 16 * ks + 8 * hh), bq = *(const bf16x8*)(Qs + l * 72 + 16 * ks + 8 * hh); acc = mfma32(af, bq, acc); }
#pragma unroll
                    for (int q = 0; q < 4; ++q) { float pv[4];
#pragma unroll
                        for (int j = 0; j < 4; ++j) { const int m = 32 * mt + 8 * q + 4 * hh + j;
                            float w;
                            if (ML) w = __expf(fminf(gvec[m] - Ml, 0.f)); else w = exp2f(lg2 * (float)max(l - m, 0));
                            w = (m <= l) ? w : 0.f;
                            pv[j] = acc[4 * q + j] * w; dsum += pv[j]; }
                        u32x2 o; o.x = pk2(pv[0], pv[1]); o.y = pk2(pv[2], pv[3]); *(u32x2*)(Ps + l * 136 + 32 * mt + 8 * q + 4 * hh) = o; }
                }
            }
            if (ML) { dsum += __shfl_xor(dsum, 32); if (hh == 0) atomicAdd(&den[l], dsum); }
            { const int m = tid & 127, dq = tid >> 7; const float w = wl[m];
              const u32x4 k1 = *(const u32x4*)(Ks + m * 72 + 16 * dq), k2 = *(const u32x4*)(Ks + m * 72 + 16 * dq + 8);
              float ka[8], kb[8]; unpack8(k1, ka); unpack8(k2, kb);
#pragma unroll
              for (int j = 0; j < 8; ++j) { Kwt[(16 * dq + j) * 136 + m] = f2bf(ka[j] * w); Kwt[(16 * dq + 8 + j) * 136 + m] = f2bf(kb[j] * w); } }
            if (ML && tid < 128) { float sacc = 0.f; const float* nv = nvec + cur * 64;
#pragma unroll
                for (int d8 = 0; d8 < 8; ++d8) { float qv[8]; unpack8(*(const u32x4*)(Qs + tid * 72 + 8 * d8), qv);
#pragma unroll
                    for (int j = 0; j < 8; ++j) sacc += qv[j] * nv[8 * d8 + j]; }
                dst[tid] = sacc; }
        }
        __syncthreads();
        f32x16 acc;
        {
#pragma unroll
            for (int i = 0; i < 16; ++i) acc[i] = 0.f;
            const bf16_t* Tc = Tt + cur * 64 * 72;
#pragma unroll
            for (int ks = 0; ks < 4; ++ks) { const bf16x8 af = *(const bf16x8*)(Tc + (32 * et + r) * 72 + 16 * ks + 8 * hh), bq = *(const bf16x8*)(Qs + l * 72 + 16 * ks + 8 * hh); acc = mfma32(af, bq, acc); }
            const float ws_ = wst[l];
#pragma unroll
            for (int i = 0; i < 16; ++i) acc[i] *= ws_;
            for (int ks = 0; ks < 2 * (lt + 1); ++ks) { const bf16x8 af = *(const bf16x8*)(Vt + (32 * et + r) * 136 + 16 * ks + 8 * hh), bp = *(const bf16x8*)(Ps + l * 136 + 16 * ks + 8 * hh); acc = mfma32(af, bp, acc); }
            if (ML) {
                const float dn = den[l] + ws_ * dst[l]; const float sc = 1.0f / fmaxf(fabsf(dn), emt[l]);
#pragma unroll
                for (int i = 0; i < 4; ++i) *(u32x2*)(stgC + ((lane >> 3) + 8 * i) * 36 + 4 * (lane & 7)) = owr[i];
                wave_lds_fence();
#pragma unroll
                for (int q = 0; q < 4; ++q) { const u32x2 ow = *(const u32x2*)(stgC + r * 36 + 8 * q + 4 * hh);
                    acc[4 * q + 0] *= sc * sigmoidf_(bflo(ow.x)); acc[4 * q + 1] *= sc * sigmoidf_(bfhi(ow.x));
                    acc[4 * q + 2] *= sc * sigmoidf_(bflo(ow.y)); acc[4 * q + 3] *= sc * sigmoidf_(bfhi(ow.y)); }
            }
            float s1 = 0.f, s2 = 0.f;
#pragma unroll
            for (int i = 0; i < 16; ++i) { s1 += acc[i]; s2 += acc[i] * acc[i]; }
            s1 += __shfl_xor(s1, 32); s2 += __shfl_xor(s2, 32);
            if (hh == 0) *(f32x2*)(stat + (et * 128 + l) * 2) = (f32x2){s1, s2};
        }
        if (wid < 4) {
            const int et2 = wid >> 1, dt2 = wid & 1;
#pragma unroll
            for (int i = 0; i < 16; ++i) accT[i] *= wsl;
#pragma unroll
            for (int ks = 0; ks < 8; ++ks) { const bf16x8 af = *(const bf16x8*)(Vt + (32 * et2 + r) * 136 + 16 * ks + 8 * hh), bk = *(const bf16x8*)(Kwt + (32 * dt2 + r) * 136 + 16 * ks + 8 * hh); accT = mfma32(af, bk, accT); }
            bf16_t* Tn = Tt + (cur ^ 1) * 64 * 72;
#pragma unroll
            for (int i = 0; i < 16; ++i) Tn[(32 * et2 + (i & 3) + 8 * (i >> 2) + 4 * hh) * 72 + 32 * dt2 + r] = f2bf(accT[i]);
        } else if (ML && wid == 4) {
            float sacc = 0.f;
#pragma unroll
            for (int m8 = 0; m8 < 16; ++m8) { float kv[8]; unpack8(*(const u32x4*)(Kwt + lane * 136 + 8 * m8), kv);
#pragma unroll
                for (int j = 0; j < 8; ++j) sacc += kv[j]; }
            nvec[(cur ^ 1) * 64 + lane] = wsl * nvec[cur * 64 + lane] + sacc;
        } else if (ML && wid == 5 && c < 15) gate_scan(c + 1);
        __syncthreads();
        {
            const f32x2 sa = *(const f32x2*)(stat + l * 2), sb = *(const f32x2*)(stat + (128 + l) * 2);
            const float mu = (sa[0] + sb[0]) * (1.0f / 64.0f), var = fmaxf((sa[1] + sb[1]) * (1.0f / 64.0f) - mu * mu, 0.f), rs = rsqrtf(var + EPS);
#pragma unroll
            for (int i = 0; i < 4; ++i) *(u32x2*)(stgD + ((lane >> 3) + 8 * i) * 36 + 4 * (lane & 7)) = gwr[i];
            wave_lds_fence();
            u32x2 wv[4];
#pragma unroll
            for (int q = 0; q < 4; ++q) { const u32x2 g2 = *(const u32x2*)(stgD + r * 36 + 8 * q + 4 * hh);
                wv[q].x = pk2((acc[4 * q] - mu) * rs * gnl[q][0] * siluf_(bflo(g2.x)), (acc[4 * q + 1] - mu) * rs * gnl[q][1] * siluf_(bfhi(g2.x)));
                wv[q].y = pk2((acc[4 * q + 2] - mu) * rs * gnl[q][2] * siluf_(bflo(g2.y)), (acc[4 * q + 3] - mu) * rs * gnl[q][3] * siluf_(bfhi(g2.y))); }
            wave_lds_fence();
#pragma unroll
            for (int q = 0; q < 4; ++q) *(u32x2*)(stgD + r * 36 + 8 * q + 4 * hh) = wv[q];
            wave_lds_fence();
            bf16_t* mp = MIX + (size_t)(tok0 + 32 * lt + (lane >> 3)) * 1024 + MIXOFF + 32 * et + 4 * (lane & 7);
#pragma unroll
            for (int i = 0; i < 4; ++i) *(u32x2*)(mp + (size_t)(8 * i) * 1024) = *(const u32x2*)(stgD + ((lane >> 3) + 8 * i) * 36 + 4 * (lane & 7));
        }
        cur ^= 1;
    }
    __syncthreads();
    const size_t sidx = (size_t)((layer * 8 + b) * 4 + h);
    if (wid < 4) { const int et2 = wid >> 1, dt2 = wid & 1; float* so = a.out + (ML ? O_MLCP : O_RETP) + sidx * 4096;
#pragma unroll
        for (int i = 0; i < 16; ++i) { const int e = 32 * et2 + (i & 3) + 8 * (i >> 2) + 4 * hh, d = 32 * dt2 + r; if (ML) so[e * 64 + d] = accT[i]; else so[d * 64 + e] = accT[i]; } }
    if (ML) { if (wid == 4) a.out[O_MLNP + sidx * 64 + lane] = nvec[cur * 64 + lane]; if (wid == 5 && lane == 0) a.out[O_MLMP + sidx] = mprev; }
}

DI void s5_prompt(const int tid, CArgs& a, int layer, int b, int g, unsigned char* sm) {
    const int wid = tid >> 6, lane = tid & 63, fr = lane & 15, fq = lane >> 4;
    float* buf = (float*)sm + wid * 16 * 132; float* Ew = (float*)(sm + 8 * 16 * 132 * 4);
    const bf16_t* proj = (const bf16_t*)(a.ws + W_PROJ); bf16_t* SY = (bf16_t*)(a.ws + W_SY);
    const int lgi = layer * 16 + g;
    const f32x2 ab = ((const f32x2*)(a.ws + W_ABAR))[lgi * 64 + lane];
    const bf16_t* bbm = (const bf16_t*)(a.ws + W_BBM) + (size_t)lgi * 128 * 16; const bf16_t* cm = (const bf16_t*)(a.ws + W_CM) + (size_t)lgi * 16 * 128;
    const bf16x8 zero8 = {0, 0, 0, 0, 0, 0, 0, 0};
    bf16x8 bbf[8], cf[4];
#pragma unroll
    for (int nt = 0; nt < 8; ++nt) bbf[nt] = lane < 32 ? *(const bf16x8*)(bbm + (16 * nt + fr) * 16 + 8 * fq) : zero8;
#pragma unroll
    for (int ks = 0; ks < 4; ++ks) cf[ks] = *(const bf16x8*)(cm + fr * 128 + 32 * ks + 8 * fq);
    const float dsk = a.in[I_S5D][layer * 256 + g * 16 + fr];
    const int tok0 = b * 2048 + 256 * wid;
    float xr = 0.f, xi = 0.f;
    const bf16_t* ubase = proj + (size_t)tok0 * NPROJ + 2304 + g * 16;
    for (int pass = 0; pass < 2; ++pass) {
        bf16x8 uf_n = lane < 32 ? *(const bf16x8*)(ubase + (size_t)fr * NPROJ + 8 * (fq & 1)) : zero8;
        bf16_t u4_n[4];
#pragma unroll
        for (int i = 0; i < 4; ++i) u4_n[i] = pass == 1 ? ubase[(size_t)(4 * fq + i) * NPROJ + fr] : (bf16_t)0;
        for (int it = 0; it < 16; ++it) {
            const bf16x8 uf = uf_n; bf16_t u4[4];
#pragma unroll
            for (int i = 0; i < 4; ++i) u4[i] = u4_n[i];
            if (it < 15) {
                uf_n = lane < 32 ? *(const bf16x8*)(ubase + (size_t)(16 * (it + 1) + fr) * NPROJ + 8 * (fq & 1)) : zero8;
                if (pass == 1) {
#pragma unroll
                    for (int i = 0; i < 4; ++i) u4_n[i] = ubase[(size_t)(16 * (it + 1) + 4 * fq + i) * NPROJ + fr]; }
            }
#pragma unroll
            for (int nt = 0; nt < 8; ++nt) { f32x4 z = {0.f, 0.f, 0.f, 0.f}; z = mfma16(uf, bbf[nt], z);
#pragma unroll
                for (int i = 0; i < 4; ++i) buf[(4 * fq + i) * 132 + 16 * nt + fr] = z[i]; }
            wave_lds_fence();
#pragma unroll
            for (int t = 0; t < 16; ++t) { const float br = buf[t * 132 + lane], bi = buf[t * 132 + 64 + lane];
                const float nr = ab.x * xr - ab.y * xi + br, ni = ab.x * xi + ab.y * xr + bi; xr = nr; xi = ni;
                if (pass == 1) { buf[t * 132 + lane] = xr; buf[t * 132 + 64 + lane] = xi; } }
            if (pass == 1) {
                wave_lds_fence();
                f32x4 y = {0.f, 0.f, 0.f, 0.f};
#pragma unroll
                for (int ks = 0; ks < 4; ++ks) { const f32x4 x0 = *(const f32x4*)(buf + fr * 132 + 32 * ks + 8 * fq), x1 = *(const f32x4*)(buf + fr * 132 + 32 * ks + 8 * fq + 4);
                    u32x4 w; w.x = pk2(x0[0], x0[1]); w.y = pk2(x0[2], x0[3]); w.z = pk2(x1[0], x1[1]); w.w = pk2(x1[2], x1[3]);
                    y = mfma16(__builtin_bit_cast(bf16x8, w), cf[ks], y); }
#pragma unroll
                for (int i = 0; i < 4; ++i) { const size_t trow = (size_t)(tok0 + 16 * it + 4 * fq + i);
                    SY[trow * 256 + g * 16 + fr] = f2bf(gelu_tanh(y[i] + dsk * bf2f(u4[i]))); }
            }
            wave_lds_fence();
        }
        if (pass == 0) {
            Ew[wid * 128 + lane] = xr; Ew[wid * 128 + 64 + lane] = xi;
            __syncthreads();
            float pr = ab.x, pi = ab.y;
#pragma unroll
            for (int s = 0; s < 8; ++s) { const float nr = pr * pr - pi * pi, ni = 2.f * pr * pi; pr = nr; pi = ni; }
            xr = 0.f; xi = 0.f;
            for (int j = 0; j < wid; ++j) { const float er = Ew[j * 128 + lane], ei = Ew[j * 128 + 64 + lane]; const float nr = pr * xr - pi * xi + er, ni = pr * xi + pi * xr + ei; xr = nr; xi = ni; }
        }
    }
    if (wid == 7) { const size_t o = (size_t)((layer * 8 + b) * 16 + g) * 64 + lane; a.out[O_S5RP + o] = xr; a.out[O_S5IP + o] = xi; }
}

DI void xattn_prompt(const int tid, CArgs& a, int layer, int b, int h, int qt, unsigned char* sm) {
    const int wid = tid >> 6, lane = tid & 63, r = lane & 31, hh = lane >> 5;
    bf16_t* Kx = (bf16_t*)sm; bf16_t* Vxt = (bf16_t*)(sm + 36864);
    const float* mk = a.out + O_MEMK + (size_t)(layer * 8 + b) * 65536 + h * 64; const float* mv = a.out + O_MEMV + (size_t)(layer * 8 + b) * 65536 + h * 64;
    const bf16_t* proj = (const bf16_t*)(a.ws + W_PROJ); bf16_t* MIX = (bf16_t*)(a.ws + W_MIX);
#pragma unroll
    for (int i = 0; i < 8; ++i) { const int idx = i * 512 + tid; { const int m = idx >> 4, d4 = idx & 15; const f32x4 v = *(const f32x4*)(mk + (size_t)m * 256 + 4 * d4); u32x2 w; w.x = pk2(v[0], v[1]); w.y = pk2(v[2], v[3]); *(u32x2*)(Kx + m * 72 + 4 * d4) = w; }
        { const int m = idx & 255, d4 = idx >> 8; const f32x4 v = *(const f32x4*)(mv + (size_t)m * 256 + 4 * d4);
#pragma unroll
          for (int j = 0; j < 4; ++j) Vxt[(4 * d4 + j) * 264 + m] = f2bf(v[j]); } }
    __syncthreads();
    const size_t trow = (size_t)b * 2048 + qt * 256 + 32 * wid + r;
    bf16x8 qf[4];
#pragma unroll
    for (int ks = 0; ks < 4; ++ks) qf[ks] = *(const bf16x8*)(proj + trow * NPROJ + 2816 + h * 64 + 16 * ks + 8 * hh);
    f32x16 acc[8];
#pragma unroll
    for (int mt = 0; mt < 8; ++mt) {
#pragma unroll
        for (int i = 0; i < 16; ++i) acc[mt][i] = 0.f;
#pragma unroll
        for (int ks = 0; ks < 4; ++ks) { const bf16x8 af = *(const bf16x8*)(Kx + (32 * mt + r) * 72 + 16 * ks + 8 * hh); acc[mt] = mfma32(af, qf[ks], acc[mt]); }
    }
    float mx = -3.0e38f;
#pragma unroll
    for (int mt = 0; mt < 8; ++mt)
#pragma unroll
        for (int i = 0; i < 16; ++i) mx = fmaxf(mx, acc[mt][i]);
    mx = fmaxf(mx, __shfl_xor(mx, 32));
    float sum = 0.f;
#pragma unroll
    for (int mt = 0; mt < 8; ++mt)
#pragma unroll
        for (int i = 0; i < 16; ++i) { const float p = exp2f((acc[mt][i] - mx) * (0.125f * 1.4426950408889634f)); acc[mt][i] = p; sum += p; }
    sum += __shfl_xor(sum, 32);
    f32x16 o[2];
#pragma unroll
    for (int et = 0; et < 2; ++et)
#pragma unroll
        for (int i = 0; i < 16; ++i) o[et][i] = 0.f;
#pragma unroll
    for (int mt = 0; mt < 8; ++mt)
#pragma unroll
        for (int s = 0; s < 2; ++s) {
            u32x4 pw; pw.x = pk2(acc[mt][8 * s], acc[mt][8 * s + 1]); pw.y = pk2(acc[mt][8 * s + 2], acc[mt][8 * s + 3]); pw.z = pk2(acc[mt][8 * s + 4], acc[mt][8 * s + 5]); pw.w = pk2(acc[mt][8 * s + 6], acc[mt][8 * s + 7]);
            const bf16x8 pb = __builtin_bit_cast(bf16x8, pw);
#pragma unroll
            for (int et = 0; et < 2; ++et) { const bf16_t* vp = Vxt + (32 * et + r) * 264 + 32 * mt + 16 * s + 4 * hh;
                const u32x2 lo = *(const u32x2*)vp, hi = *(const u32x2*)(vp + 8); u32x4 aw; aw.x = lo.x; aw.y = lo.y; aw.z = hi.x; aw.w = hi.y;
                o[et] = mfma32(__builtin_bit_cast(bf16x8, aw), pb, o[et]); }
        }
    const float inv = 1.0f / sum;
#pragma unroll
    for (int et = 0; et < 2; ++et)
#pragma unroll
        for (int q = 0; q < 4; ++q) { const int e0 = 32 * et + 8 * q + 4 * hh; const u32x2 gw = *(const u32x2*)(proj + trow * NPROJ + 3072 + h * 64 + e0);
            u32x2 w; w.x = pk2(o[et][4 * q] * inv * siluf_(bflo(gw.x)), o[et][4 * q + 1] * inv * siluf_(bfhi(gw.x))); w.y = pk2(o[et][4 * q + 2] * inv * siluf_(bflo(gw.y)), o[et][4 * q + 3] * inv * siluf_(bfhi(gw.y)));
            *(u32x2*)(MIX + trow * 1024 + 768 + h * 64 + e0) = w; }
}

DI void ret_sample(const int tid, CArgs& a, int layer, int id) {
    const int lane = tid & 63, b = id >> 2, h = id & 3;
    const bf16_t* prow = (const bf16_t*)(a.ws + W_PROJ) + (size_t)(MP + b) * NPROJ; const float* rope = (const float*)(a.ws + W_ROPE) + (size_t)2048 * 64;
    const float co = rope[2 * (lane & 31)], si = rope[2 * (lane & 31) + 1];
    float q = bf2f(prow[h * 64 + lane]), k = bf2f(prow[256 + h * 64 + lane]); const float v = bf2f(prow[512 + h * 64 + lane]);
    { const float qp = __shfl_xor(q, 32), kp = __shfl_xor(k, 32); q = lane < 32 ? q * co - qp * si : qp * si + q * co; k = (lane < 32 ? k * co - kp * si : kp * si + k * co) * 0.125f; }
    const float qk = wave_sum(q * k), gam = 1.0f - exp2f(-5.0f - (float)h);
    const size_t sidx = (size_t)((layer * 128 + b) * 4 + h) * 4096;
    const float* S0 = a.in[I_SRET] + sidx; float* So = a.out + O_RETS + sidx;
    const int sub = lane >> 4, e4 = lane & 15;
    f32x4 v4; v4[0] = __shfl(v, 4 * e4); v4[1] = __shfl(v, 4 * e4 + 1); v4[2] = __shfl(v, 4 * e4 + 2); v4[3] = __shfl(v, 4 * e4 + 3);
    f32x4 acc = {0.f, 0.f, 0.f, 0.f};
#pragma unroll 4
    for (int it = 0; it < 16; ++it) { const int d = 4 * it + sub; const f32x4 s4 = *(const f32x4*)(S0 + d * 64 + 4 * e4); const float qd = __shfl(q, d), kd = __shfl(k, d);
        acc += qd * s4; *(f32x4*)(So + d * 64 + 4 * e4) = gam * s4 + kd * v4; }
#pragma unroll
    for (int j = 0; j < 4; ++j) { acc[j] += __shfl_xor(acc[j], 16); acc[j] += __shfl_xor(acc[j], 32); }
    f32x4 o = qk * v4 + gam * acc;
    float s = o[0] + o[1] + o[2] + o[3]; s += __shfl_xor(s, 1); s += __shfl_xor(s, 2); s += __shfl_xor(s, 4); s += __shfl_xor(s, 8); const float mu = s * (1.0f / 64.0f);
    o -= mu; float q2 = o[0] * o[0] + o[1] * o[1] + o[2] * o[2] + o[3] * o[3]; q2 += __shfl_xor(q2, 1); q2 += __shfl_xor(q2, 2); q2 += __shfl_xor(q2, 4); q2 += __shfl_xor(q2, 8);
    const float rs = rsqrtf(q2 * (1.0f / 64.0f) + EPS);
    if (sub == 0) { const float* gn = a.in[I_RGN] + layer * 256 + h * 64 + 4 * e4; const u32x2 gw = *(const u32x2*)(prow + 768 + h * 64 + 4 * e4);
        u32x2 w; w.x = pk2(o[0] * rs * gn[0] * siluf_(bflo(gw.x)), o[1] * rs * gn[1] * siluf_(bfhi(gw.x))); w.y = pk2(o[2] * rs * gn[2] * siluf_(bflo(gw.y)), o[3] * rs * gn[3] * siluf_(bfhi(gw.y)));
        *(u32x2*)((bf16_t*)(a.ws + W_MIX) + (size_t)(MP + b) * 1024 + h * 64 + 4 * e4) = w; }
}
DI void mlstm_sample(const int tid, CArgs& a, int layer, int id) {
    const int lane = tid & 63, b = id >> 2, h = id & 3;
    const bf16_t* prow = (const bf16_t*)(a.ws + W_PROJ) + (size_t)(MP + b) * NPROJ; const float gp[8] = {bf2f(prow[3328]), bf2f(prow[3329]), bf2f(prow[3330]), bf2f(prow[3331]), bf2f(prow[3332]), bf2f(prow[3333]), bf2f(prow[3334]), bf2f(prow[3335])};
    const float q = bf2f(prow[1024 + h * 64 + lane]), k = bf2f(prow[1280 + h * 64 + lane]) * 0.125f, v = bf2f(prow[1536 + h * 64 + lane]), mo = bf2f(prow[1792 + h * 64 + lane]), mg = bf2f(prow[2048 + h * 64 + lane]);
    const float gi = gp[h] + a.in[I_BI][layer * 4 + h], lf = logsigf_(gp[4 + h] + a.in[I_BF][layer * 4 + h]);
    const size_t hidx = (size_t)((layer * 128 + b) * 4 + h);
    const float m0 = a.in[I_SM][hidx], aa = lf + m0, mt = fmaxf(aa, gi), wi = __expf(gi - mt), wsx = __expf(aa - mt);
    const float s = wave_sum(q * k) * wi; const float n0 = a.in[I_SN][hidx * 64 + lane]; const float den = s + wsx * wave_sum(n0 * q);
    const float sc = 1.0f / fmaxf(fabsf(den), __expf(-mt));
    const float* C0 = a.in[I_SC] + hidx * 4096; float* Co = a.out + O_MLCS + hidx * 4096;
    const int sub = lane >> 4, d4 = lane & 15;
    f32x4 q4, k4;
#pragma unroll
    for (int j = 0; j < 4; ++j) { q4[j] = __shfl(q, 4 * d4 + j); k4[j] = __shfl(k, 4 * d4 + j); }
    float hv[16]; float hs = 0.f;
#pragma unroll
    for (int it = 0; it < 16; ++it) { const int e = 4 * it + sub; const f32x4 c4 = *(const f32x4*)(C0 + e * 64 + 4 * d4);
        float dot = c4[0] * q4[0] + c4[1] * q4[1] + c4[2] * q4[2] + c4[3] * q4[3]; dot += __shfl_xor(dot, 1); dot += __shfl_xor(dot, 2); dot += __shfl_xor(dot, 4); dot += __shfl_xor(dot, 8);
        const float ve = __shfl(v, e), moe = __shfl(mo, e);
        *(f32x4*)(Co + e * 64 + 4 * d4) = wsx * c4 + (wi * ve) * k4;
        hv[it] = (s * ve + wsx * dot) * sc * sigmoidf_(moe); hs += hv[it]; }
    hs += __shfl_xor(hs, 16); hs += __shfl_xor(hs, 32); const float mu = hs * (1.0f / 64.0f);
    float q2 = 0.f;
#pragma unroll
    for (int it = 0; it < 16; ++it) { hv[it] -= mu; q2 += hv[it] * hv[it]; }
    q2 += __shfl_xor(q2, 16); q2 += __shfl_xor(q2, 32); const float rs = rsqrtf(q2 * (1.0f / 64.0f) + EPS);
    const float* gn = a.in[I_MGN] + layer * 256 + h * 64; bf16_t* mp = (bf16_t*)(a.ws + W_MIX) + (size_t)(MP + b) * 1024 + 256 + h * 64;
#pragma unroll
    for (int it = 0; it < 16; ++it) { const int e = 4 * it + sub; const float g = __shfl(mg, e); if (d4 == 0) mp[e] = f2bf(hv[it] * rs * gn[e] * siluf_(g)); }
    a.out[O_MLNS + hidx * 64 + lane] = wsx * n0 + wi * k;
    if (lane == 0) a.out[O_MLMS + hidx] = mt;
}
DI void s5_sample(const int tid, CArgs& a, int layer, int id) {
    const int lane = tid & 63, b = id >> 4, g = id & 15, lgi = layer * 16 + g;
    const bf16_t* prow = (const bf16_t*)(a.ws + W_PROJ) + (size_t)(MP + b) * NPROJ;
    const float uu = bf2f(prow[2304 + g * 16 + (lane & 15)]);
    const size_t sidx = (size_t)((layer * 128 + b) * 16 + g) * 64 + lane;
    const float x0r = a.in[I_S5R][sidx], x0i = a.in[I_S5I][sidx];
    const f32x2 ab = ((const f32x2*)(a.ws + W_ABAR))[lgi * 64 + lane];
    const f32x4* bb = (const f32x4*)((const f32x2*)(a.ws + W_BBF) + (size_t)(lgi * 64 + lane) * 16);
    float bur = 0.f, bui = 0.f;
#pragma unroll
    for (int c2 = 0; c2 < 8; ++c2) { const f32x4 w = bb[c2]; const float u0 = __shfl(uu, 2 * c2), u1 = __shfl(uu, 2 * c2 + 1); bur += w[0] * u0 + w[2] * u1; bui += w[1] * u0 + w[3] * u1; }
    const float xr = ab.x * x0r - ab.y * x0i + bur, xi = ab.x * x0i + ab.y * x0r + bui;
    a.out[O_S5RS + sidx] = xr; a.out[O_S5IS + sidx] = xi;
    float y = 0.f;
#pragma unroll
    for (int ch = 0; ch < 16; ++ch) { const size_t ci = ((size_t)lgi * 16 + ch) * 64 + lane; const float t = wave_sum(a.in[I_CRE][ci] * xr - a.in[I_CIM][ci] * xi); if (lane == ch) y = t; }
    if (lane < 16) { y += a.in[I_S5D][layer * 256 + g * 16 + lane] * uu; ((bf16_t*)(a.ws + W_SY))[(size_t)(MP + b) * 256 + g * 16 + lane] = f2bf(gelu_tanh(y)); }
}
DI void xattn_sample(const int tid, CArgs& a, int layer, int b, unsigned char* sm) {
    const int wid = tid >> 6, lane = tid & 63, hd = lane >> 4, j16 = lane & 15;
    float* sc = (float*)sm; float* po = sc + 1024;
    const bf16_t* prow = (const bf16_t*)(a.ws + W_PROJ) + (size_t)(MP + b) * NPROJ;
    const u32x2 qw = *(const u32x2*)(prow + 2816 + 4 * lane); const f32x4 q4 = {bflo(qw.x), bfhi(qw.x), bflo(qw.y), bfhi(qw.y)};
    const float* Kc = a.in[I_CK] + (size_t)(layer * 128 + b) * 65536 + 4 * lane; const float* Vc = a.in[I_CV] + (size_t)(layer * 128 + b) * 65536 + 4 * lane;
#pragma unroll 16
    for (int i = 0; i < 32; ++i) { const int m = 32 * wid + i; const f32x4 k4 = *(const f32x4*)(Kc + (size_t)m * 256);
        float dot = k4[0] * q4[0] + k4[1] * q4[1] + k4[2] * q4[2] + k4[3] * q4[3]; dot += __shfl_xor(dot, 1); dot += __shfl_xor(dot, 2); dot += __shfl_xor(dot, 4); dot += __shfl_xor(dot, 8);
        if (j16 == 0) sc[hd * 256 + m] = dot * 0.125f; }
    __syncthreads();
    float mx = -3.0e38f;
#pragma unroll
    for (int t = 0; t < 16; ++t) mx = fmaxf(mx, sc[hd * 256 + j16 + 16 * t]);
    mx = fmaxf(mx, __shfl_xor(mx, 1)); mx = fmaxf(mx, __shfl_xor(mx, 2)); mx = fmaxf(mx, __shfl_xor(mx, 4)); mx = fmaxf(mx, __shfl_xor(mx, 8));
    float sum = 0.f;
#pragma unroll
    for (int t = 0; t < 16; ++t) sum += __expf(sc[hd * 256 + j16 + 16 * t] - mx);
    sum += __shfl_xor(sum, 1); sum += __shfl_xor(sum, 2); sum += __shfl_xor(sum, 4); sum += __shfl_xor(sum, 8);
    const float inv = 1.0f / sum;
    f32x4 acc = {0.f, 0.f, 0.f, 0.f};
#pragma unroll 16
    for (int i = 0; i < 32; ++i) { const int m = 32 * wid + i; const f32x4 v4 = *(const f32x4*)(Vc + (size_t)m * 256); const float p = __expf(sc[hd * 256 + m] - mx) * inv; acc += p * v4; }
    *(f32x4*)(po + wid * 256 + 4 * lane) = acc;
    __syncthreads();
    if (tid < 256) { float o = 0.f;
#pragma unroll
        for (int w = 0; w < 8; ++w) o += po[w * 256 + tid];
        ((bf16_t*)(a.ws + W_MIX))[(size_t)(MP + b) * 1024 + 768 + tid] = f2bf(o * siluf_(bf2f(prow[3072 + tid]))); }
}

DI void task_done(const int tid, unsigned* dep) {
    asm volatile("s_waitcnt vmcnt(0)" ::: "memory");
    __syncthreads();
    if (tid == 0) { __threadfence(); __hip_atomic_fetch_add(dep, 1u, __ATOMIC_RELAXED, __HIP_MEMORY_SCOPE_AGENT); }
}
DI void glu_task(const int tid, CArgs& a, int layer, int pm, unsigned* dep0, unsigned char* sm) {
    if (tid == 0) {
        unsigned* dep = dep0 + 16 * (pm < 64 ? (pm >> 3) : 8); const unsigned need = pm < 64 ? 16u : 256u; unsigned sp = 0;
        while (__hip_atomic_load(dep, __ATOMIC_RELAXED, __HIP_MEMORY_SCOPE_AGENT) < need && ++sp < (1u << 22)) __builtin_amdgcn_s_sleep(2);
        __threadfence();
    }
    __syncthreads();
    unsigned char* ws = a.ws;
    pg8::Gemm g; pg8::Epi E; g.ready = nullptr; g.need = 0; g.gate_pm = -1;
    g.A = (const bf16_t*)(ws + W_SY); g.Bt = (const bf16_t*)(ws + W_WGLUT) + (size_t)layer * 65536; g.M = MPAD; g.N = 256; g.K = 256;
    E.mode = 2; E.O = (bf16_t*)(ws + W_MIX); E.SY = (const bf16_t*)(ws + W_SY); E.PROJ = (const bf16_t*)(ws + W_PROJ); E.out = a.out; E.src = a.out; E.xbuf = nullptr; E.pcnt = nullptr; E.nw = nullptr; E.XNo = nullptr;
    pg8::StaticOrder S; S.init_single(pm);
    pg8::gemm_phase(tid, (LAS unsigned char*)sm, g, S, E);
}
DI void phase_mixers(CArgs& a, int layer, unsigned char* sm) {
    unsigned* ctr = (unsigned*)(a.ws + W_CTL) + 16 * layer;
    unsigned* dep0 = (unsigned*)(a.ws + W_CTL) + 256 + 160 * layer;
    volatile int* slot = (volatile int*)(sm + LDS_CTL);
    for (;;) {
        int tid = threadIdx.x; asm volatile("" : "+v"(tid)); const int wid = tid >> 6;
        __syncthreads();
        if (tid == 0) *slot = (int)atomicAdd(ctr, 1u);
        __syncthreads();
        const int t = *slot;
        if (t >= (layer == 0 ? 1256 : 1025)) break;
        if (t < 32) seq_mixer<false>(tid, a, layer, t >> 2, t & 3, sm);
        else if (t < 64) seq_mixer<true>(tid, a, layer, (t - 32) >> 2, (t - 32) & 3, sm);
        else if (t < 192) { s5_prompt(tid, a, layer, (t - 64) >> 4, (t - 64) & 15, sm); task_done(tid, dep0 + 16 * ((t - 64) >> 4)); }
        else if (t < 448) { s5_sample(tid, a, layer, (t - 192) * 8 + wid); task_done(tid, dep0 + 16 * 8); }
        else if (t < 576) xattn_sample(tid, a, layer, t - 448, sm);
        else if (t < 832) { const int u = t - 576; xattn_prompt(tid, a, layer, u >> 5, (u >> 3) & 3, u & 7, sm); }
        else if (t < 896) ret_sample(tid, a, layer, (t - 832) * 8 + wid);
        else if (t < 960) mlstm_sample(tid, a, layer, (t - 896) * 8 + wid);
        else if (t < 1025) glu_task(tid, a, layer, t - 960, dep0, sm);
        else prep_task(tid, a, t - 1025, sm);
    }
}

DI void outproj_sample(const int tid, CArgs& a, int layer, const float* src) {
    const int wid = tid >> 6, lane = tid & 63, fr = lane & 15, fq = lane >> 4;
    const bf16_t* A = (const bf16_t*)(a.ws + W_MIX) + (size_t)MP * 1024; const bf16_t* Bt = (const bf16_t*)(a.ws + W_WOUTT) + (size_t)layer * 1024 * 1024;
    for (int t = blockIdx.x * 8 + wid; t < 512; t += gridDim.x * 8) {
        const int mi = t >> 6, ni = t & 63; f32x4 acc = {0.f, 0.f, 0.f, 0.f};
        const bf16_t* ap = A + (size_t)(16 * mi + fr) * 1024 + 8 * fq; const bf16_t* bp = Bt + (size_t)(16 * ni + fr) * 1024 + 8 * fq;
#pragma unroll 8
        for (int ks = 0; ks < 32; ++ks) acc = mfma16(*(const bf16x8*)(ap + 32 * ks), *(const bf16x8*)(bp + 32 * ks), acc);
#pragma unroll
        for (int i = 0; i < 4; ++i) { const size_t row = (size_t)(16 * mi + 4 * fq + i), col = (size_t)(16 * ni + fr); a.out[O_YS + row * 1024 + col] = src[row * 1024 + col] + acc[i]; }
    }
}

#define XB_TMO      128
#define XB_XCNT(j)  (256  + 64 * (j))
#define XB_XSUB(j)  (1280 + 64 * (j))
#define XB_XGEN(j)  (2304 + 64 * (j))
#define XB_TOP      3328
#define XB_TOPGEN   3392
#define XCD_BAR_WORDS 3456
#define XB_SPIN_CAP (1u << 18)
DI unsigned xb_ld(unsigned* p)              { return __hip_atomic_load(p, __ATOMIC_RELAXED, __HIP_MEMORY_SCOPE_AGENT); }
DI unsigned xb_add(unsigned* p, unsigned v) { return __hip_atomic_fetch_add(p, v, __ATOMIC_RELAXED, __HIP_MEMORY_SCOPE_AGENT); }
DI unsigned xb_xcc_id() { return (unsigned)__builtin_amdgcn_s_getreg((3 << 11) | 20) & 0xFu; }
#define XB_SPIN(cond, bar) do { unsigned _sp = 0; while (cond) { __builtin_amdgcn_s_sleep(1); \
    if ((++_sp & 255u) == 0u) { if (xb_ld(&(bar)[XB_TMO])) break; if (_sp > XB_SPIN_CAP) { atomicAdd(&(bar)[XB_TMO], 1u); break; } } } } while (0)
struct XcdBarrier { unsigned* bar; unsigned x; volatile LAS unsigned* st; };
DI XcdBarrier xcd_barrier_post(unsigned* bar, volatile LAS unsigned* st) {
    XcdBarrier b; b.bar = bar; b.x = xb_xcc_id(); b.st = st;
    if (threadIdx.x == 0) (void)xb_add(&bar[XB_XCNT(b.x)], 1u);
    return b;
}
DI void xcd_barrier_complete(unsigned* bar, unsigned x, unsigned& nloc, unsigned& nx) {
    const unsigned G = gridDim.x * gridDim.y * gridDim.z;
    unsigned sum, cnt, mine, sp = 0u;
    for (;;) {
        sum = 0u; cnt = 0u; mine = 0u;
#pragma unroll
        for (unsigned j = 0; j < 16; ++j) { const unsigned c = xb_ld(&bar[XB_XCNT(j)]); sum += c; cnt += (c > 0u) ? 1u : 0u; mine = (j == x) ? c : mine; }
        if (sum == G) break;
        __builtin_amdgcn_s_sleep(1);
        if ((++sp & 255u) == 0u) { if (xb_ld(&bar[XB_TMO])) break; if (sp > XB_SPIN_CAP) { atomicAdd(&bar[XB_TMO], 1u); break; } }
    }
    nloc = mine > 0u ? mine : 1u; nx = cnt > 0u ? cnt : 1u;
}
DI void xcd_barrier(const XcdBarrier& b) {
    asm volatile("s_waitcnt vmcnt(0)" ::: "memory");
    __syncthreads();
    if (threadIdx.x == 0) {
        unsigned* bar = b.bar;
        __builtin_amdgcn_s_waitcnt(0);
        unsigned nloc = b.st[0], nx = b.st[1];
        if (nloc == 0u) { xcd_barrier_complete(bar, b.x, nloc, nx); b.st[0] = nloc; b.st[1] = nx; }
        const unsigned old = xb_add(&bar[XB_XSUB(b.x)], 1u);
        const unsigned gen = old / nloc;
        if (old + 1u == (gen + 1u) * nloc) {
            __builtin_amdgcn_fence(__ATOMIC_RELEASE, "agent");
            asm volatile("s_waitcnt vmcnt(0)" ::: "memory");
            const unsigned og = xb_add(&bar[XB_TOP], 1u);
            const unsigned tg = og / nx;
            if (og + 1u == (tg + 1u) * nx) xb_add(&bar[XB_TOPGEN], 1u);
            else XB_SPIN(xb_ld(&bar[XB_TOPGEN]) == tg, bar);
            __builtin_amdgcn_fence(__ATOMIC_ACQUIRE, "agent");
            xb_add(&bar[XB_XGEN(b.x)], 1u);
            asm volatile("s_waitcnt vmcnt(0)" ::: "memory");
        } else {
            XB_SPIN(xb_ld(&bar[XB_XGEN(b.x)]) == gen, bar);
            __builtin_amdgcn_fence(__ATOMIC_ACQUIRE, "agent");
            asm volatile("s_waitcnt vmcnt(0)" ::: "memory");
        }
    }
    __syncthreads();
}
DI void seam(unsigned char* shm) {
    CArgs* kp = (CArgs*)__builtin_amdgcn_kernarg_segment_ptr(); asm volatile("" : "+s"(kp));
    XcdBarrier b; b.bar = (unsigned*)(kp->ws + W_BAR); b.x = xb_xcc_id(); b.st = (volatile LAS unsigned*)(LAS unsigned char*)(shm + LDS_CTL + 16);
    xcd_barrier(b);
}

#ifndef FUSE_PRE
#define FUSE_PRE 1
#endif
constexpr int NPH = 9;
template <int ph>
DI void run_phase(unsigned char* shm) {
    LAS unsigned char* lds = (LAS unsigned char*)shm;
    const int G = (int)gridDim.x, bid = (int)blockIdx.x;
    constexpr int layer = ph >= 4 ? 1 : 0;
    int tid = threadIdx.x; asm volatile("" : "+v"(tid));
    CArgs* kp = (CArgs*)__builtin_amdgcn_kernarg_segment_ptr(); asm volatile("" : "+s"(kp)); CArgs& a = *kp;
    unsigned char* ws = a.ws;
    if constexpr (ph == 0 || ph == 4) { if (ph == 0) phase_prep(tid, a, shm);
        phase_norm(tid, a, layer, ph ? a.out : a.in[I_XP], ph ? a.out + O_YS : a.in[I_XS], shm, !(ph == 4 && G == 256 && FUSE_PRE)); }
    else if constexpr (ph == 2 || ph == 6) phase_mixers(a, layer, shm);
    else if constexpr (ph == 8) phase_final_norm(tid, a);
    else {
        constexpr int nsub = ph == 1 ? 2 : 1;
        const bool gate5 = ph == 5 && G == 256 && FUSE_PRE;
        unsigned* depX = (unsigned*)(ws + W_CTL) + 672;
        if (gate5 && bid >= G - 16) { norm_sample_rows(tid, a, 1, a.out + O_YS); task_done(tid, depX); }
        for (int sub = 0; sub < nsub; ++sub) {
            pg8::Gemm g; pg8::Epi E; int c = bid; g.ready = nullptr; g.need = 0; g.gate_pm = -1;
            E.O = (bf16_t*)(ws + W_PROJ); E.SY = (const bf16_t*)(ws + W_SY); E.PROJ = (const bf16_t*)(ws + W_PROJ); E.out = a.out; E.src = a.out;
            E.xbuf = (float*)(ws + (ph == 3 ? W_XB2 : W_XB)); E.pcnt = (unsigned*)(ws + W_PCNT) + (ph == 3 ? 1024 : 0); E.nw = ph == 3 ? a.in[I_NW] + 1024 : a.in[I_FNW]; E.XNo = (bf16_t*)(ws + W_XN);
            if (ph == 1 || ph == 5) {
                if (sub == 0) { g.A = (const bf16_t*)(ws + W_XN); g.Bt = (const bf16_t*)(ws + W_WINT) + (size_t)layer * NPROJ * 1024; g.M = MPAD; g.N = NPROJ; g.K = 1024; E.mode = 0; if (gate5) { g.ready = depX; g.need = 16u; g.gate_pm = 64; } }
                else { g.A = (const bf16_t*)(ws + W_MEMB); g.Bt = (const bf16_t*)(ws + W_WMEMT); g.M = 2048; g.N = 1024; g.K = 1024; E.mode = 1; c = G - 1 - bid; }
            } else { g.A = (const bf16_t*)(ws + W_MIX); g.Bt = (const bf16_t*)(ws + W_WOUTT) + (size_t)layer * 1024 * 1024; g.M = MP; g.N = 1024; g.K = 1024; E.mode = G == 256 ? (ph == 7 ? 4 : (FUSE_PRE ? 5 : 3)) : 3; E.src = layer ? a.out : a.in[I_XP]; }
            pg8::StaticOrder S; S.init(g.M, g.N, G, c);
            pg8::gemm_phase(tid, lds, g, S, E);
        }
        if (ph == 1) { const int blo = G == 256 ? 142 : 0, bhi = G == 256 ? 224 : G;
            if (bid >= blo && bid < bhi)
#pragma unroll 1
            for (int j = bid - blo; j < 436; j += bhi - blo) prep_tile(tid, a, j < 256 ? 1920 + j : (j < 272 ? 2448 + (j - 256) : 832 + 668 + (j - 272)), (float*)shm);
        }
        if (ph == 3 || ph == 7) outproj_sample(tid, a, layer, layer ? a.out + O_YS : a.in[I_XS]);
        if (G == 256 && ph == 7) {
            unsigned* depS = (unsigned*)(ws + W_CTL) + (ph == 3 ? 656 : 640);
            if (bid < 64) task_done(tid, depS);
            else if (bid < 192) {
                if (tid == 0) { unsigned sp = 0; while (__hip_atomic_load(depS, __ATOMIC_RELAXED, __HIP_MEMORY_SCOPE_AGENT) < 64u && ++sp < (1u << 22)) __builtin_amdgcn_s_sleep(2); __threadfence(); }
                __syncthreads();
                if (tid < 64) { float* p = a.out + O_YS + (size_t)(bid - 64) * 1024; const float* nw = ph == 3 ? a.in[I_NW] + 1024 : a.in[I_FNW]; f32x4 x[4]; float ss = 0.f;
#pragma unroll
                    for (int i = 0; i < 4; ++i) { x[i] = *(const f32x4*)(p + 256 * i + 4 * tid); ss += x[i][0] * x[i][0] + x[i][1] * x[i][1] + x[i][2] * x[i][2] + x[i][3] * x[i][3]; }
                    ss = wave_sum(ss); const float rstd = rsqrtf(ss * (1.0f / 1024.0f) + EPS);
#pragma unroll
                    for (int i = 0; i < 4; ++i) { const f32x4 w = *(const f32x4*)(nw + 256 * i + 4 * tid); const f32x4 y = x[i] * rstd * w;
                        if (ph == 7) *(f32x4*)(p + 256 * i + 4 * tid) = y;
                        else { u32x2 o; o.x = pk2(y[0], y[1]); o.y = pk2(y[2], y[3]); *(u32x2*)((bf16_t*)(ws + W_XN) + (size_t)(MP + bid - 64) * 1024 + 256 * i + 4 * tid) = o; } } }
            }
        }
    }
}

__global__ __launch_bounds__(512, 2) void mk_fwd(Args a_) {
    extern __shared__ __attribute__((aligned(16))) unsigned char shm[];
    cg::grid_group grid = cg::this_grid();
    const int lo = a_.ph_lo, hi = a_.ph_hi;
    if (hi - lo > 1) {
        if (threadIdx.x < 4) ((volatile LAS unsigned*)(LAS unsigned char*)(shm + LDS_CTL + 16))[threadIdx.x] = 0u;
        __syncthreads();
        CArgs* kp = (CArgs*)__builtin_amdgcn_kernarg_segment_ptr();
        (void)xcd_barrier_post((unsigned*)(kp->ws + W_BAR), (volatile LAS unsigned*)(LAS unsigned char*)(shm + LDS_CTL + 16));
    }
    if (hi > 1000) grid.sync();
#define RUN_PHASE(P) if (P >= lo && P < hi) { run_phase<P>(shm); if (P + 1 < hi) seam(shm); }
    const bool fusedn = gridDim.x == 256 && lo == 0 && hi == NPH;
    RUN_PHASE(0) RUN_PHASE(1) RUN_PHASE(2)
    RUN_PHASE(3)
    if (!(fusedn && FUSE_PRE)) { RUN_PHASE(4) }
    RUN_PHASE(5) RUN_PHASE(6)
    if (fusedn) { run_phase<7>(shm); } else { RUN_PHASE(7) RUN_PHASE(8) }
#undef RUN_PHASE
}

#ifndef N_LAUNCH_PER_PHASE
#define N_LAUNCH_PER_PHASE 0
#endif
extern "C" void kernel_launch(void* const* d_in, const int* in_sizes, int n_in, void* d_out, int out_size, void* d_ws, size_t ws_size, hipStream_t stream) {
    static int grid = 0;
    if (grid == 0) {
        if (n_in != 30 || ws_size < W_END) { fprintf(stderr, "kernel_launch: unexpected n_in %d / ws %zu (need %zu)\n", n_in, ws_size, (size_t)W_END); grid = -1; return; }
        int dev = 0, cus = 0, per_cu = 0;
        hipGetDevice(&dev); hipDeviceGetAttribute(&cus, hipDeviceAttributeMultiprocessorCount, dev);
        if (hipFuncSetAttribute((const void*)mk_fwd, hipFuncAttributeMaxDynamicSharedMemorySize, LDS_BYTES) != hipSuccess) { fprintf(stderr, "kernel_launch: hipFuncSetAttribute failed\n"); grid = -1; return; }
        if (hipOccupancyMaxActiveBlocksPerMultiprocessor(&per_cu, (const void*)mk_fwd, 512, LDS_BYTES) != hipSuccess || per_cu < 1) { fprintf(stderr, "kernel_launch: occupancy query says %d\n", per_cu); per_cu = 1; }
        (void)hipGetLastError();
        grid = cus * per_cu;
    }
    if (grid < 0) return;
    if (hipMemsetAsync(d_ws, 0, W_WINT, stream) != hipSuccess) { fprintf(stderr, "kernel_launch: hipMemsetAsync failed\n"); return; }
    Args a{};
    for (int i = 0; i < 30; ++i) a.in[i] = (const float*)d_in[i];
    a.out = (float*)d_out; a.ws = (unsigned char*)d_ws;
#if N_LAUNCH_PER_PHASE
    for (int ph = 0; ph < NPH; ++ph) { if (grid == 256 && (ph == 4 || ph == 8)) continue; a.ph_lo = ph; a.ph_hi = ph + 1; hipLaunchKernelGGL(mk_fwd, dim3(grid), dim3(512), LDS_BYTES, stream, a); }
#else
    a.ph_lo = 0; a.ph_hi = NPH;
    void* args[] = {&a};
    hipError_t e = hipLaunchCooperativeKernel((const void*)mk_fwd, dim3(grid), dim3(512), args, LDS_BYTES, stream);
    if (e != hipSuccess) fprintf(stderr, "cooperative launch failed: %s (grid %d)\n", hipGetErrorString(e), grid);
#endif
}
```

```cpp
#include <hip/hip_runtime.h>
#include <hip/hip_cooperative_groups.h>
#include <cstdio>
#include <cstdint>
namespace cg = cooperative_groups;

#define DI __device__ __forceinline__
#define LAS __attribute__((address_space(3)))
typedef unsigned short bf16_t;
typedef short bf16x8 __attribute__((ext_vector_type(8)));
typedef float f32x4 __attribute__((ext_vector_type(4)));
typedef float f32x2 __attribute__((ext_vector_type(2)));
typedef float f32x16 __attribute__((ext_vector_type(16)));
typedef unsigned u32x4 __attribute__((ext_vector_type(4)));
typedef unsigned u32x2 __attribute__((ext_vector_type(2)));
typedef __bf16 bfv2 __attribute__((ext_vector_type(2)));

constexpr int D = 1024, MP = 16384, MS = 128, MT = MP + MS, MPAD = 16640, NPROJ = 3584  , DIN = 3336;
constexpr int LDS_BYTES = 148480, LDS_CTL = 147456;
constexpr float EPS = 1e-6f;
constexpr size_t O_YP = 0, O_YS = 16777216, O_RETP = O_YS + 131072, O_RETS = O_RETP + 262144, O_MLCP = O_RETS + 4194304,
                 O_MLCS = O_MLCP + 262144, O_MLNP = O_MLCS + 4194304, O_MLNS = O_MLNP + 4096, O_MLMP = O_MLNS + 65536,
                 O_MLMS = O_MLMP + 64, O_S5RP = O_MLMS + 1024, O_S5RS = O_S5RP + 16384, O_S5IP = O_S5RS + 262144,
                 O_S5IS = O_S5IP + 16384, O_MEMK = O_S5IS + 262144, O_MEMV = O_MEMK + 1048576;
constexpr size_t W_CTL = 0, W_BAR = 4096, W_PCNT = 20480  , W_WINT = 32768, W_WOUTT = W_WINT + 2ull * NPROJ * 1024 * 2, W_WMEMT = W_WOUTT + 2ull * 1024 * 1024 * 2,
                 W_WGLUT = W_WMEMT + 1024ull * 1024 * 2, W_MEMB = W_WGLUT + 2ull * 256 * 256 * 2, W_ROPE = W_MEMB + 2048ull * 1024 * 2,
                 W_ABAR = W_ROPE + 2049ull * 32 * 2 * 4 + 256, W_BBF = W_ABAR + 2ull * 16 * 64 * 2 * 4, W_BBM = W_BBF + 2ull * 16 * 64 * 16 * 2 * 4,
                 W_CM = W_BBM + 2ull * 16 * 128 * 16 * 2, W_XN = W_CM + 2ull * 16 * 16 * 128 * 2, W_GATES = W_XN + (size_t)MPAD * 1024 * 2,
                 W_PROJ = W_GATES + (size_t)MT * 8 * 4, W_SY = W_PROJ + (size_t)MPAD * NPROJ * 2, W_MIX = W_SY + (size_t)MPAD * 256 * 2,
                 W_XB = W_MIX + (size_t)MPAD * 1024 * 2,
                 W_XB2 = W_XB + 16384ull * 4 * 4,
                 W_END = W_XB2 + 16384ull * 4 * 4;

struct Args { const float* in[30]; float* out; unsigned char* ws; int ph_lo, ph_hi; };
typedef const Args __attribute__((address_space(4))) CArgs;
enum { I_XP = 0, I_XS, I_MEM, I_SRET, I_SC, I_SN, I_SM, I_S5R, I_S5I, I_CK, I_CV, I_NW, I_WIN, I_RGN, I_BI, I_BF, I_MGN,
       I_ARE, I_AIM, I_LDT, I_BRE, I_BIM, I_CRE, I_CIM, I_S5D, I_WGLU, I_WMK, I_WMV, I_WOUT, I_FNW };

DI unsigned pk2(float lo, float hi) { f32x2 v = {lo, hi}; bfv2 r = __builtin_convertvector(v, bfv2); return __builtin_bit_cast(unsigned, r); }
DI bf16_t f2bf(float f) { return (bf16_t)(pk2(f, 0.f) & 0xffffu); }
DI float bf2f(bf16_t b) { return __uint_as_float(((unsigned)b) << 16); }
DI float bflo(unsigned w) { return __uint_as_float(w << 16); }
DI float bfhi(unsigned w) { return __uint_as_float(w & 0xffff0000u); }
DI float wave_sum(float v) { for (int o = 32; o > 0; o >>= 1) v += __shfl_xor(v, o); return v; }
DI float sigmoidf_(float x) { return 1.0f / (1.0f + __expf(-x)); }
DI float siluf_(float x) { return x / (1.0f + __expf(-x)); }
DI float gelu_tanh(float y) { const float z = 0.7978845608028654f * (y + 0.044715f * y * y * y); const float t = 1.0f - 2.0f / (1.0f + __expf(2.0f * z)); return 0.5f * y * (1.0f + t); }
DI float logsigf_(float x) { return fminf(x, 0.f) - log1pf(__expf(-fabsf(x))); }
DI f32x16 mfma32(bf16x8 a, bf16x8 b, f32x16 c) { return __builtin_amdgcn_mfma_f32_32x32x16_bf16(a, b, c, 0, 0, 0); }
DI f32x4 mfma16(bf16x8 a, bf16x8 b, f32x4 c) { return __builtin_amdgcn_mfma_f32_16x16x32_bf16(a, b, c, 0, 0, 0); }
DI void unpack8(u32x4 w, float (&f)[8]) { f[0] = bflo(w.x); f[1] = bfhi(w.x); f[2] = bflo(w.y); f[3] = bfhi(w.y); f[4] = bflo(w.z); f[5] = bfhi(w.z); f[6] = bflo(w.w); f[7] = bfhi(w.w); }
DI u32x4 pack8(const float (&f)[8]) { u32x4 w; w.x = pk2(f[0], f[1]); w.y = pk2(f[2], f[3]); w.z = pk2(f[4], f[5]); w.w = pk2(f[6], f[7]); return w; }
DI void wave_lds_fence() { asm volatile("" ::: "memory"); __builtin_amdgcn_wave_barrier(); asm volatile("s_waitcnt lgkmcnt(0)" ::: "memory"); }
DI void sincos_f(float a, float& s, float& c) {
    const float n = rintf(a * 0.15915494309189535f);
    float r = fmaf(-n, 6.2831854820251465f, a); r = fmaf(-n, -1.7484555e-7f, r);
    const float x = r * 0.25f, x2 = x * x;
    const float sp = x * (1.0f + x2 * (-1.6666667e-1f + x2 * (8.3333333e-3f + x2 * (-1.9841270e-4f + x2 * 2.7557319e-6f))));
    const float cp = 1.0f + x2 * (-0.5f + x2 * (4.1666667e-2f + x2 * (-1.3888889e-3f + x2 * (2.4801587e-5f + x2 * -2.7557319e-7f))));
    const float s2 = 2.0f * sp * cp, c2 = 1.0f - 2.0f * sp * sp;
    s = 2.0f * s2 * c2; c = 1.0f - 2.0f * s2 * s2;
}

namespace pg8 {
constexpr int BM = 256, BK = 64, HALF = 128, HTB = HALF * BK * 2, STAGE_BYTES = 8 * HTB, NXCD = 8, WGM = 8;
__host__ __device__ __forceinline__ int lds_byte(int r, int c) { const int st = (r >> 4) * 2 + (c >> 5), rr = r & 15, cc = c & 31, ob = rr * 64 + cc * 2; return st * 1024 + (ob ^ (((ob >> 9) & 1) << 5)); }
__host__ __device__ __forceinline__ void stage_rc(int b, int& R, int& C) { const int st = b / 1024, sb = b % 1024, swz = sb ^ (((sb >> 9) & 1) << 5); R = (st >> 1) * 16 + swz / 64; C = (st & 1) * 32 + (swz % 64) / 2; }
__host__ __device__ __forceinline__ int perm32(int rho) { const int n = rho >> 4, i = rho & 15; return 8 * (i >> 2) + 4 * n + (i & 3); }
struct Unit { int pm, pn; };
struct Gemm { const bf16_t* A; const bf16_t* Bt; int M, N, K; const unsigned* ready; unsigned need; int gate_pm; };
struct StaticOrder {
    int nM, nN, nwg, G, c, direct;
    __device__ void init(int M, int N, int G_, int c_) { nM = M / BM; nN = N / BM; nwg = nM * nN; G = G_; c = c_; direct = 0; }
    __device__ void init_single(int pm) { nM = nN = nwg = G = 1; c = pm; direct = 1; }
    __device__ bool next(int i, Unit& u) const {
        if (direct) { if (i) return false; u.pm = c; u.pn = 0; return true; }
        const long L = (long)i * G + c; if (L >= nwg) return false;
        int wgid = (int)L; { const int q = nwg / NXCD, r = nwg % NXCD, xcd = wgid % NXCD, off = wgid / NXCD; wgid = (xcd < r ? xcd * (q + 1) : r * (q + 1) + (xcd - r) * q) + off; }
        const int nig = WGM * nN, gid = wgid / nig, fm = gid * WGM, gsz = (nM - fm) < WGM ? (nM - fm) : WGM;
        u.pm = fm + ((wgid % nig) % gsz); u.pn = (wgid % nig) / gsz; return true;
    }
};
struct Epi {
    int mode; bf16_t* O; const bf16_t* SY; const bf16_t* PROJ; float* out; const float* src;
    float* xbuf; unsigned* pcnt; const float* nw; bf16_t* XNo;
    DI bool perm() const { return mode == 0 || mode == 2; }
    DI void fused(f32x4 (&acc)[2][2][4][2], const Unit& u, int wr, int wc, int fr, int fq, LAS unsigned char* lds, int wid, int lane) const {
        LAS float* P = (LAS float*)lds; LAS float* S = (LAS float*)(lds + 4096);
        const int rloc = wr * 64 + fr, col0 = u.pn * BM + wc * 32 + 4 * fq;
#pragma unroll
        for (int ai = 0; ai < 2; ++ai)
#pragma unroll
            for (int m = 0; m < 4; ++m) { const size_t o = (size_t)(u.pm * BM + rloc + ai * HALF + m * 16) * 1024 + col0; float ss = 0.f;
#pragma unroll
                for (int bj = 0; bj < 2; ++bj)
#pragma unroll
                    for (int n = 0; n < 2; ++n) { const f32x4 sv = *(const f32x4*)(src + o + bj * HALF + n * 16); const f32x4 x = acc[ai][bj][m][n] + sv; acc[ai][bj][m][n] = x;
                        ss += (x[0] * x[0] + x[1] * x[1]) + (x[2] * x[2] + x[3] * x[3]); }
                ss += __shfl_xor(ss, 16); ss += __shfl_xor(ss, 32);
                if (fq == 0) P[(rloc + ai * HALF + m * 16) * 4 + wc] = ss;
                if (m & 1) __builtin_amdgcn_sched_barrier(0); }
        asm volatile("s_waitcnt lgkmcnt(0)" ::: "memory"); __builtin_amdgcn_s_barrier(); asm volatile("" ::: "memory");
        const int row = wid * 32 + (lane & 31);
        if (lane < 32) { const float t = (P[row * 4] + P[row * 4 + 1]) + (P[row * 4 + 2] + P[row * 4 + 3]);
            __hip_atomic_store(xbuf + (size_t)(u.pm * BM + row) * 4 + u.pn, t, __ATOMIC_RELAXED, __HIP_MEMORY_SCOPE_AGENT); }
        asm volatile("s_waitcnt vmcnt(0)" ::: "memory");
        if (lane == 0) __hip_atomic_fetch_add(pcnt + 16 * u.pm, 1u, __ATOMIC_RELAXED, __HIP_MEMORY_SCOPE_AGENT);
        if (wid == 0) {
            unsigned sp = 0;
            while ((unsigned)__builtin_amdgcn_readfirstlane(__hip_atomic_load(pcnt + 16 * u.pm, __ATOMIC_RELAXED, __HIP_MEMORY_SCOPE_AGENT)) < 32u && ++sp < (1u << 22)) __builtin_amdgcn_s_sleep(2);
            __builtin_amdgcn_fence(__ATOMIC_ACQUIRE, "agent");
        }
        asm volatile("s_waitcnt vmcnt(0) lgkmcnt(0)" ::: "memory"); __builtin_amdgcn_s_barrier(); asm volatile("" ::: "memory");
        if (lane < 32) { const float* slot = xbuf + (size_t)(u.pm * BM + row) * 4; float q = 0.f;
#pragma unroll
            for (int t = 0; t < 4; ++t) q += __hip_atomic_load(slot + t, __ATOMIC_RELAXED, __HIP_MEMORY_SCOPE_AGENT);
            S[row] = rsqrtf(q * (1.0f / 1024.0f) + EPS); }
        asm volatile("s_waitcnt lgkmcnt(0)" ::: "memory"); __builtin_amdgcn_s_barrier(); asm volatile("" ::: "memory");
#pragma unroll
        for (int ai = 0; ai < 2; ++ai)
#pragma unroll
            for (int m = 0; m < 4; ++m) { const size_t o = (size_t)(u.pm * BM + rloc + ai * HALF + m * 16) * 1024 + col0; const float rs = S[rloc + ai * HALF + m * 16];
#pragma unroll
                for (int bj = 0; bj < 2; ++bj)
#pragma unroll
                    for (int n = 0; n < 2; ++n) { const f32x4 w4 = *(const f32x4*)(nw + col0 + bj * HALF + n * 16); const f32x4 y = acc[ai][bj][m][n] * rs * w4;
                        if (mode == 4) *(f32x4*)(out + o + bj * HALF + n * 16) = y;
                        else { *(f32x4*)(out + o + bj * HALF + n * 16) = acc[ai][bj][m][n]; u32x2 w; w.x = pk2(y[0], y[1]); w.y = pk2(y[2], y[3]); *(u32x2*)(XNo + o + bj * HALF + n * 16) = w; } } }
    }
    DI void operator()(const f32x4 (&acc)[2][2][4][2], const Unit& u, int wr, int wc, int fr, int fq) const {
        const int row0 = u.pm * BM + wr * 64 + fr;
        if (mode == 0) {
            const int col0 = u.pn * BM + wc * 32 + 8 * fq;
#pragma unroll
            for (int ai = 0; ai < 2; ++ai)
#pragma unroll
                for (int m = 0; m < 4; ++m) { bf16_t* rowp = O + (size_t)(row0 + ai * HALF + m * 16) * NPROJ + col0;
#pragma unroll
                    for (int bj = 0; bj < 2; ++bj) { const f32x4 v0 = acc[ai][bj][m][0], v1 = acc[ai][bj][m][1];
                        u32x4 w; w.x = pk2(v0[0], v0[1]); w.y = pk2(v0[2], v0[3]); w.z = pk2(v1[0], v1[1]); w.w = pk2(v1[2], v1[3]);
                        *(u32x4*)(rowp + bj * HALF) = w; } }
        } else if (mode == 2) {
            const int col0 = wc * 32 + 8 * fq;
#pragma unroll
            for (int ai = 0; ai < 2; ++ai)
#pragma unroll
                for (int m = 0; m < 4; ++m) { const size_t row = (size_t)(row0 + ai * HALF + m * 16);
#pragma unroll
                    for (int bj = 0; bj < 2; ++bj) { const int col = col0 + bj * HALF;
                        const u32x4 syw = *(const u32x4*)(SY + row * 256 + col), sgw = *(const u32x4*)(PROJ + row * NPROJ + 2560 + col);
                        float sy[8], sg[8], o[8]; unpack8(syw, sy); unpack8(sgw, sg);
                        const f32x4 v0 = acc[ai][bj][m][0], v1 = acc[ai][bj][m][1];
#pragma unroll
                        for (int j = 0; j < 4; ++j) { o[j] = sy[j] * sigmoidf_(v0[j]) * siluf_(sg[j]); o[4 + j] = sy[4 + j] * sigmoidf_(v1[j]) * siluf_(sg[4 + j]); }
                        *(u32x4*)(O + row * 1024 + 512 + col) = pack8(o); }
                    if (m & 1) __builtin_amdgcn_sched_barrier(0); }
        } else if (mode == 1) {
            float* C = out + ((u.pn & 1) ? O_MEMV : O_MEMK) + (size_t)(u.pn >> 1) * 524288;
            const int col0 = wc * 32 + 4 * fq;
#pragma unroll
            for (int ai = 0; ai < 2; ++ai)
#pragma unroll
                for (int m = 0; m < 4; ++m) { float* rowp = C + (size_t)(row0 + ai * HALF + m * 16) * 256 + col0;
#pragma unroll
                    for (int bj = 0; bj < 2; ++bj)
#pragma unroll
                        for (int n = 0; n < 2; ++n) *(f32x4*)(rowp + bj * HALF + n * 16) = acc[ai][bj][m][n]; }
        } else {
            const int col0 = u.pn * BM + wc * 32 + 4 * fq;
#pragma unroll
            for (int ai = 0; ai < 2; ++ai)
#pragma unroll
                for (int m = 0; m < 4; ++m) { const size_t o = (size_t)(row0 + ai * HALF + m * 16) * 1024 + col0;
#pragma unroll
                    for (int bj = 0; bj < 2; ++bj)
#pragma unroll
                        for (int n = 0; n < 2; ++n) { const f32x4 sv = *(const f32x4*)(src + o + bj * HALF + n * 16); *(f32x4*)(out + o + bj * HALF + n * 16) = sv + acc[ai][bj][m][n]; }
                    if (m & 1) __builtin_amdgcn_sched_barrier(0); }
        }
    }
};

DI void a_ready_wait(const Gemm& g, int wid) {
    if (wid == 0) { unsigned sp = 0;
        while ((unsigned)__builtin_amdgcn_readfirstlane(__hip_atomic_load(g.ready, __ATOMIC_RELAXED, __HIP_MEMORY_SCOPE_AGENT)) < g.need && ++sp < (1u << 22)) __builtin_amdgcn_s_sleep(2);
        __builtin_amdgcn_fence(__ATOMIC_ACQUIRE, "agent");
        asm volatile("s_waitcnt vmcnt(0)" ::: "memory"); }
    asm volatile("" ::: "memory"); __builtin_amdgcn_s_barrier(); asm volatile("" ::: "memory");
}
DI void gemm_phase(const int tid, LAS unsigned char* lds, const Gemm g, const StaticOrder& S, const Epi& E) {
    const int wid = __builtin_amdgcn_readfirstlane(tid >> 6), lane = tid & 63, wr = wid >> 2, wc = wid & 3, fr = lane & 15, fq = lane >> 4;
    const int K = g.K, nt = K / BK;
    unsigned voffA[2], voffB[2];
#pragma unroll
    for (int i = 0; i < 2; ++i) { int R, C; stage_rc(tid * 16 + i * 8192, R, C); const int Rb = E.perm() ? ((R & ~31) + perm32(R & 31)) : R;
        voffA[i] = (unsigned)(R * K + C) * 2u; voffB[i] = (unsigned)(Rb * K + C) * 2u; }
    const size_t kstep = (size_t)(BK * 2);
    const size_t hstep = (size_t)HALF * K * 2;
    const size_t tstep = 2 * hstep;
    const unsigned ldsw = (unsigned)wid * 1024u;
    const int aoff = lds_byte(wr * 64 + fr, fq * 8), boff = lds_byte(wc * 32 + fr, fq * 8);
#define PG8_SA(b, h) (((b) * 2 + (h)) * HTB)
#define PG8_SB(b, h) ((4 + (b) * 2 + (h)) * HTB)
#define PG8_STAGE(bufoff, gbase, voff) do { _Pragma("unroll") for (int _i = 0; _i < 2; ++_i) \
        __builtin_amdgcn_global_load_lds((const unsigned*)((const char*)(gbase) + (voff)[_i]), (LAS unsigned*)(lds + (bufoff) + ldsw + _i * 8192), 16, 0, 0); } while (0)
#define PG8_LDA(dst, b, h) do { _Pragma("unroll") for (int m = 0; m < 4; ++m) _Pragma("unroll") for (int k = 0; k < 2; ++k) dst[m][k] = *(const LAS bf16x8*)(lds + PG8_SA(b, h) + aoff + m * 2048 + k * 1024); } while (0)
#define PG8_LDB(dst, b, h) do { _Pragma("unroll") for (int n = 0; n < 2; ++n) _Pragma("unroll") for (int k = 0; k < 2; ++k) dst[n][k] = *(const LAS bf16x8*)(lds + PG8_SB(b, h) + boff + n * 2048 + k * 1024); } while (0)
#define PG8_MMA(ai, bj, At, Bt) do { __builtin_amdgcn_s_setprio(1); _Pragma("unroll") for (int m = 0; m < 4; ++m) _Pragma("unroll") for (int n = 0; n < 2; ++n) _Pragma("unroll") for (int k = 0; k < 2; ++k) \
        acc[ai][bj][m][n] = __builtin_amdgcn_mfma_f32_16x16x32_bf16(Bt[n][k], At[m][k], acc[ai][bj][m][n], 0, 0, 0); __builtin_amdgcn_s_setprio(0); } while (0)
#define PG8_WAIT_V(n) asm volatile("s_waitcnt vmcnt(" #n ")" ::: "memory")
#define PG8_WAIT_L(n) asm volatile("s_waitcnt lgkmcnt(" #n ")" ::: "memory")
#define PG8_BAR __builtin_amdgcn_s_barrier()
#define PG8_SCHED __builtin_amdgcn_sched_barrier(0)
    Unit cur, nxt; int ui = 0;
    if (!S.next(0, cur)) return;
    f32x4 acc[2][2][4][2];
#pragma unroll
    for (int a = 0; a < 2; ++a)
#pragma unroll
        for (int b = 0; b < 2; ++b)
#pragma unroll
            for (int m = 0; m < 4; ++m)
#pragma unroll
                for (int n = 0; n < 2; ++n) acc[a][b][m][n] = (f32x4){0.f, 0.f, 0.f, 0.f};
    bf16x8 At[4][2], B0[2][2], B1[2][2];
    const char* cA = (const char*)g.A + (size_t)cur.pm * tstep; const char* cB = (const char*)g.Bt + (size_t)cur.pn * tstep;
    if (g.ready && cur.pm == g.gate_pm) a_ready_wait(g, wid);
    PG8_STAGE(PG8_SB(0, 0), cB, voffB); PG8_STAGE(PG8_SA(0, 0), cA, voffA); PG8_STAGE(PG8_SB(0, 1), cB + hstep, voffB); PG8_STAGE(PG8_SA(0, 1), cA + hstep, voffA);
    if (wr == 1) PG8_BAR;
    PG8_WAIT_V(4); PG8_BAR;
    PG8_STAGE(PG8_SB(1, 0), cB + kstep, voffB); PG8_STAGE(PG8_SA(1, 0), cA + kstep, voffA); PG8_STAGE(PG8_SB(1, 1), cB + hstep + kstep, voffB);
    PG8_WAIT_V(6); PG8_BAR;
    for (;;) {
        const bool has_next = S.next(ui + 1, nxt);
        const char* nA = has_next ? (const char*)g.A + (size_t)nxt.pm * tstep : cA; const char* nB = has_next ? (const char*)g.Bt + (size_t)nxt.pn * tstep : cB;
        for (int t = 0; t < nt; t += 2) {
            const bool last = (t == nt - 2);
            const char* a1 = cA + (size_t)(t + 1) * kstep;
            const char* a2 = last ? nA : cA + (size_t)(t + 2) * kstep; const char* b2 = last ? nB : cB + (size_t)(t + 2) * kstep;
            const char* a3 = a2 + kstep; const char* b3 = b2 + kstep;
            if (last && has_next && g.ready && nxt.pm == g.gate_pm) a_ready_wait(g, wid);
            PG8_LDB(B0, 0, 0); PG8_SCHED; PG8_LDA(At, 0, 0); PG8_STAGE(PG8_SA(1, 1), a1 + hstep, voffA);
            PG8_WAIT_L(8); PG8_BAR; PG8_WAIT_L(0); PG8_MMA(0, 0, At, B0); PG8_BAR; PG8_SCHED;
            PG8_LDB(B1, 0, 1); PG8_STAGE(PG8_SB(0, 0), b2, voffB);
            PG8_BAR; PG8_WAIT_L(0); PG8_MMA(0, 1, At, B1); PG8_BAR;
            PG8_LDA(At, 0, 1); PG8_STAGE(PG8_SA(0, 0), a2, voffA);
            PG8_BAR; PG8_WAIT_L(0); PG8_MMA(1, 0, At, B0); PG8_BAR; PG8_SCHED;
            PG8_STAGE(PG8_SB(0, 1), b2 + hstep, voffB);
            PG8_WAIT_V(6); PG8_BAR; PG8_MMA(1, 1, At, B1); PG8_BAR;
            PG8_LDB(B0, 1, 0); PG8_SCHED; PG8_LDA(At, 1, 0); PG8_STAGE(PG8_SA(0, 1), a2 + hstep, voffA);
            PG8_WAIT_L(8); PG8_BAR; PG8_WAIT_L(0); PG8_MMA(0, 0, At, B0); PG8_BAR; PG8_SCHED;
            PG8_LDB(B1, 1, 1); PG8_STAGE(PG8_SB(1, 0), b3, voffB);
            PG8_BAR; PG8_WAIT_L(0); PG8_MMA(0, 1, At, B1); PG8_BAR;
            PG8_LDA(At, 1, 1); PG8_STAGE(PG8_SA(1, 0), a3, voffA);
            PG8_BAR; PG8_WAIT_L(0); PG8_MMA(1, 0, At, B0); PG8_BAR; PG8_SCHED;
            PG8_STAGE(PG8_SB(1, 1), b3 + hstep, voffB);
            PG8_WAIT_V(6); PG8_BAR; PG8_MMA(1, 1, At, B1); PG8_BAR;
        }
        if (E.mode < 4) E(acc, cur, wr, wc, fr, fq);
        if (!has_next) break;
#pragma unroll
        for (int a = 0; a < 2; ++a)
#pragma unroll
            for (int b = 0; b < 2; ++b)
#pragma unroll
                for (int m = 0; m < 4; ++m)
#pragma unroll
                    for (int n = 0; n < 2; ++n) acc[a][b][m][n] = (f32x4){0.f, 0.f, 0.f, 0.f};
        cur = nxt; cA = nA; cB = nB; ++ui;
    }
    PG8_WAIT_V(0);
    if (wr == 0) PG8_BAR;
    PG8_BAR;
    if (E.mode >= 4) E.fused(acc, cur, wr, wc, fr, fq, lds, wid, lane);
#undef PG8_SA
#undef PG8_SB
#undef PG8_STAGE
#undef PG8_LDA
#undef PG8_LDB
#undef PG8_MMA
#undef PG8_WAIT_V
#undef PG8_WAIT_L
#undef PG8_BAR
#undef PG8_SCHED
}
}

DI void transpose_tile(const int tid, const float* src, int ld_src, int col0, int k0, bf16_t* dst, int n0, int K, float* tile) {
#pragma unroll
    for (int i = 0; i < 8; ++i) { const int kk = i * 8 + (tid >> 6), nn = tid & 63; tile[kk * 65 + nn] = src[(size_t)(k0 + kk) * ld_src + col0 + nn]; }
    __syncthreads();
#pragma unroll
    for (int i = 0; i < 8; ++i) { const int nn = i * 8 + (tid >> 6), kk = tid & 63; dst[(size_t)(n0 + nn) * K + k0 + kk] = f2bf(tile[kk * 65 + nn]); }
    __syncthreads();
}

DI void prep_tile(const int tid, CArgs& a, int t, float* tile) {
    unsigned char* ws = a.ws;
    if (t < 1664) { const int l = t / 832, r = t % 832, kt = r / 52, nt = r % 52; const int n0 = nt * 64;
        transpose_tile(tid, a.in[I_WIN] + (size_t)l * 1024 * DIN, DIN, n0 + (n0 >= 2304 ? 8 : 0), kt * 64, (bf16_t*)(ws + W_WINT) + (size_t)l * NPROJ * 1024, n0, 1024, tile); }
    else if (t < 2176) { const int u = t - 1664, l = u / 256, r = u % 256, kt = r / 16, nt = r % 16;
        transpose_tile(tid, a.in[I_WOUT] + (size_t)l * 1024 * 1024, 1024, nt * 64, kt * 64, (bf16_t*)(ws + W_WOUTT) + (size_t)l * 1024 * 1024, nt * 64, 1024, tile); }
    else if (t < 2432) { const int u = t - 2176, lk = u / 64, r = u % 64, kt = r / 4, nt = r % 4; const int l = lk >> 1, kv = lk & 1;
        transpose_tile(tid, a.in[kv ? I_WMV : I_WMK] + (size_t)l * 1024 * 256, 256, nt * 64, kt * 64, (bf16_t*)(ws + W_WMEMT) + (size_t)lk * 256 * 1024, nt * 64, 1024, tile); }
    else { const int u = t - 2432, l = u / 16, r = u % 16, kt = r / 4, nt = r % 4;
        transpose_tile(tid, a.in[I_WGLU] + (size_t)l * 65536, 256, nt * 64, kt * 64, (bf16_t*)(ws + W_WGLUT) + (size_t)l * 65536, nt * 64, 256, tile); }
}
DI void prep_gate_rows(CArgs& a, int i0, int iend, int stride, int l) {
    for (int i = i0; i < iend; i += stride) { const int n = i >> 10, k = i & 1023;
        ((bf16_t*)(a.ws + W_WINT))[((size_t)l * NPROJ + 3328 + n) * 1024 + k] = n < 8 ? f2bf(a.in[I_WIN][((size_t)l * 1024 + k) * DIN + 2304 + n]) : (bf16_t)0; }
}
DI void prep_task(const int tid, CArgs& a, int k, unsigned char* sm) {
    if (k < 278) {
#pragma unroll 1
        for (int j = 3 * k; j < 3 * k + 3 && j < 832; ++j) prep_tile(tid, a, 832 + j, (float*)sm);
    } else prep_gate_rows(a, (k - 278) * 32768 + tid, (k - 277) * 32768, 512, 1);
}
DI void phase_prep(const int tid, CArgs& a, unsigned char* sm) {
    const int nb = gridDim.x, bid = blockIdx.x;
    unsigned char* ws = a.ws;
    float* tile = (float*)sm;
#pragma unroll 1
    for (int t = bid; t < 1360; t += nb) prep_tile(tid, a, t < 832 ? t : (t < 1088 ? 1664 + (t - 832) : (t < 1344 ? 2176 + (t - 1088) : 2432 + (t - 1344))), tile);
    prep_gate_rows(a, bid * 512 + tid, 256 * 1024, nb * 512, 0);
    { const f32x4* src = (const f32x4*)a.in[I_MEM]; u32x2* dst = (u32x2*)(ws + W_MEMB);
#pragma unroll 2
      for (int i = bid * 512 + tid; i < 2048 * 1024 / 4; i += nb * 512) { const f32x4 v = src[i]; u32x2 w; w.x = pk2(v[0], v[1]); w.y = pk2(v[2], v[3]); dst[i] = w; } }
    { float* rope = (float*)(ws + W_ROPE);
#pragma unroll 1
      for (int i = bid * 512 + tid; i < 2049 * 32; i += nb * 512) { const int pr = i >> 5, j = i & 31; const float pos = pr == 2048 ? 16384.0f : (float)pr;
          const float inv = exp2f(-(float)j * (13.287712379549449f / 32.0f)); float sn, cs; sincos_f(pos * inv, sn, cs); rope[2 * i] = cs; rope[2 * i + 1] = sn; } }
#pragma unroll 1
    for (int i = bid * 512 + tid; i < 2048; i += nb * 512) {
        const int lg = i >> 6, p = i & 63;
        const float dt = __expf(a.in[I_LDT][lg]), are = a.in[I_ARE][i], aim = a.in[I_AIM][i];
        const float xx = are * dt, yy = aim * dt, ex1 = expm1f(xx), ex = ex1 + 1.0f;
        float sn, cs, sh, chh; sincos_f(yy, sn, cs); sincos_f(0.5f * yy, sh, chh);
        const float abr = ex * cs, abi = ex * sn, den = are * are + aim * aim, nr = ex1 - 2.0f * ex * sh * sh, ni = abi;
        const float fr = (nr * are + ni * aim) / den, fi = (ni * are - nr * aim) / den;
        ((f32x2*)(ws + W_ABAR))[i] = (f32x2){abr, abi};
        f32x2* bbf = (f32x2*)(ws + W_BBF) + (size_t)i * 16; bf16_t* bbm = (bf16_t*)(ws + W_BBM) + (size_t)lg * 128 * 16; bf16_t* cm = (bf16_t*)(ws + W_CM) + (size_t)lg * 16 * 128;
#pragma unroll 1
        for (int cc = 0; cc < 16; ++cc) { const float bre = a.in[I_BRE][(size_t)i * 16 + cc], bim = a.in[I_BIM][(size_t)i * 16 + cc];
            const float br = fr * bre - fi * bim, bi = fr * bim + fi * bre;
            bbf[cc] = (f32x2){br, bi}; bbm[p * 16 + cc] = f2bf(br); bbm[(64 + p) * 16 + cc] = f2bf(bi); }
#pragma unroll 1
        for (int ch = 0; ch < 16; ++ch) { cm[ch * 128 + p] = f2bf(a.in[I_CRE][((size_t)lg * 16 + ch) * 64 + p]); cm[ch * 128 + 64 + p] = f2bf(-a.in[I_CIM][((size_t)lg * 16 + ch) * 64 + p]); }
    }
}

DI void norm_sample_rows(const int tid, CArgs& a, int layer, const float* xs) {
    const int wid = tid >> 6, lane = tid & 63, j = ((int)blockIdx.x - ((int)gridDim.x - 16)) * 8 + wid;
    if (j < 0 || j >= MS) return;
    const float* nw = a.in[I_NW] + layer * 1024; const float* src = xs + (size_t)j * 1024; bf16_t* dst = (bf16_t*)(a.ws + W_XN) + (size_t)(MP + j) * 1024;
    f32x4 x[4]; float ss = 0.f;
#pragma unroll
    for (int i = 0; i < 4; ++i) { x[i] = *(const f32x4*)(src + 256 * i + 4 * lane); ss += x[i][0] * x[i][0] + x[i][1] * x[i][1] + x[i][2] * x[i][2] + x[i][3] * x[i][3]; }
    ss = wave_sum(ss); const float rstd = rsqrtf(ss * (1.0f / 1024.0f) + EPS);
#pragma unroll
    for (int i = 0; i < 4; ++i) { const int d0 = 256 * i + 4 * lane; const f32x4 w = *(const f32x4*)(nw + d0);
        u32x2 o; o.x = pk2(x[i][0] * rstd * w[0], x[i][1] * rstd * w[1]); o.y = pk2(x[i][2] * rstd * w[2], x[i][3] * rstd * w[3]); *(u32x2*)(dst + d0) = o; }
}
DI void phase_norm(const int tid, CArgs& a, int layer, const float* xp, const float* xs, unsigned char* sm, bool prompt_rows = true) {
    const int wid = tid >> 6, lane = tid & 63;
    const float* nw = a.in[I_NW] + layer * 1024;
    bf16_t* XN = (bf16_t*)(a.ws + W_XN);
    if (prompt_rows) {
        f32x4 xn_[4];
        { const int row = blockIdx.x * 8 + wid; if (row < MP) {
#pragma unroll
            for (int i = 0; i < 4; ++i) xn_[i] = *(const f32x4*)(xp + (size_t)row * 1024 + 256 * i + 4 * lane); } }
        for (int row = blockIdx.x * 8 + wid; row < MP; row += gridDim.x * 8) {
            f32x4 x[4]; float ss = 0.f;
#pragma unroll
            for (int i = 0; i < 4; ++i) { x[i] = xn_[i]; ss += x[i][0] * x[i][0] + x[i][1] * x[i][1] + x[i][2] * x[i][2] + x[i][3] * x[i][3]; }
            { const int nrow = row + gridDim.x * 8; if (nrow < MP) {
#pragma unroll
                for (int i = 0; i < 4; ++i) xn_[i] = *(const f32x4*)(xp + (size_t)nrow * 1024 + 256 * i + 4 * lane); } }
            ss = wave_sum(ss);
            const float rstd = rsqrtf(ss * (1.0f / 1024.0f) + EPS);
#pragma unroll
            for (int i = 0; i < 4; ++i) { const int d0 = 256 * i + 4 * lane; const f32x4 w = *(const f32x4*)(nw + d0);
                u32x2 o; o.x = pk2(x[i][0] * rstd * w[0], x[i][1] * rstd * w[1]); o.y = pk2(x[i][2] * rstd * w[2], x[i][3] * rstd * w[3]); *(u32x2*)(XN + (size_t)row * 1024 + d0) = o; }
        }
    }
    norm_sample_rows(tid, a, layer, xs);
}
DI void phase_final_norm(const int tid, CArgs& a) {
    const int wid = tid >> 6, lane = tid & 63; const float* nw = a.in[I_FNW];
    f32x4 xn_[4];
    { const int row = blockIdx.x * 8 + wid; if (row < MT) {
#pragma unroll
        for (int i = 0; i < 4; ++i) xn_[i] = *(const f32x4*)(a.out + (size_t)row * 1024 + 256 * i + 4 * lane); } }
    for (int row = blockIdx.x * 8 + wid; row < MT; row += gridDim.x * 8) {
        float* p = a.out + (size_t)row * 1024; f32x4 x[4]; float ss = 0.f;
#pragma unroll
        for (int i = 0; i < 4; ++i) { x[i] = xn_[i]; ss += x[i][0] * x[i][0] + x[i][1] * x[i][1] + x[i][2] * x[i][2] + x[i][3] * x[i][3]; }
        { const int nrow = row + gridDim.x * 8; if (nrow < MT) {
#pragma unroll
            for (int i = 0; i < 4; ++i) xn_[i] = *(const f32x4*)(a.out + (size_t)nrow * 1024 + 256 * i + 4 * lane); } }
        ss = wave_sum(ss); const float rstd = rsqrtf(ss * (1.0f / 1024.0f) + EPS);
#pragma unroll
        for (int i = 0; i < 4; ++i) { const f32x4 w = *(const f32x4*)(nw + 256 * i + 4 * lane); *(f32x4*)(p + 256 * i + 4 * lane) = x[i] * rstd * w; }
    }
}

template <bool ML>
DI void seq_mixer(const int tid, CArgs& a, int layer, int b, int h, unsigned char* sm) {
    const int wid = tid >> 6, lane = tid & 63, r = lane & 31, hh = lane >> 5;
    bf16_t* Qs = (bf16_t*)(sm); bf16_t* Ks = (bf16_t*)(sm + 18432); bf16_t* Vt = (bf16_t*)(sm + 36864); bf16_t* Kwt = (bf16_t*)(sm + 54272);
    bf16_t* Ps = (bf16_t*)(sm + 71680); bf16_t* Tt = (bf16_t*)(sm + 106496);
    float* vecs = (float*)(sm + 124928);
    float* den = vecs + 1280; float* dst = den + 128; float* nvec = dst + 128; float* stat = nvec + 128;
    const bf16_t* proj = (const bf16_t*)(a.ws + W_PROJ); bf16_t* MIX = (bf16_t*)(a.ws + W_MIX);
    const float* rope = (const float*)(a.ws + W_ROPE);
    const int QOFF = (ML ? 1024 : 0) + h * 64, KOFF = QOFF + 256, VOFF = QOFF + 512, OOFF = 1792 + h * 64, GOFF = (ML ? 2048 : 768) + h * 64, MIXOFF = (ML ? 256 : 0) + h * 64;
    const float* gn = a.in[ML ? I_MGN : I_RGN] + layer * 256 + h * 64;
    const float lg2 = log2f(1.0f - exp2f(-5.0f - (float)h));
    const int lt = wid >> 1, et = wid & 1, l = 32 * lt + r;
    for (int i = tid; i < 64 * 72; i += 512) Tt[i] = 0;
    if (tid < 64) nvec[tid] = 0.f;
    if (!ML && tid < 128) { vecs[tid] = exp2f(lg2 * (float)(tid + 1)); vecs[512 + tid] = exp2f(lg2 * (float)(127 - tid)); }
    f32x16 accT;
#pragma unroll
    for (int i = 0; i < 16; ++i) accT[i] = 0.f;
    float mprev = 0.f; const float bi_ = ML ? a.in[I_BI][layer * 4 + h] : 0.f, bf_ = ML ? a.in[I_BF][layer * 4 + h] : 0.f;
    int cur = 0;
    const int pl = tid & 127, pd8 = tid >> 7, ql = tid >> 2, qc = tid & 3;
    f32x4 gnl[4];
#pragma unroll
    for (int q = 0; q < 4; ++q) gnl[q] = *(const f32x4*)(gn + 32 * et + 8 * q + 4 * hh);
    u32x4 nq1, nq2, nk1, nk2, nv1, nv2; f32x4 ncs[4]; float ng0 = 0.f, ng1 = 0.f, ng2 = 0.f, ng3 = 0.f;
    auto issue_chunk = [&](int cc) {
        const bf16_t* base = proj + (size_t)(b * 2048 + cc * 128 + pl) * NPROJ; const bf16_t* baseq = proj + (size_t)(b * 2048 + cc * 128 + ql) * NPROJ;
        nq1 = *(const u32x4*)(baseq + QOFF + 8 * qc); nq2 = *(const u32x4*)(baseq + QOFF + 32 + 8 * qc);
        nk1 = *(const u32x4*)(baseq + KOFF + 8 * qc); nk2 = *(const u32x4*)(baseq + KOFF + 32 + 8 * qc);
        nv1 = *(const u32x4*)(base + VOFF + 8 * pd8); nv2 = *(const u32x4*)(base + VOFF + 32 + 8 * pd8);
        if (!ML) { const float* cs = rope + ((size_t)(cc * 128 + ql) * 32 + 8 * qc) * 2;
#pragma unroll
            for (int q = 0; q < 4; ++q) ncs[q] = *(const f32x4*)(cs + 4 * q); }
        if (ML && wid == 5) { const bf16_t* gp = proj + (size_t)(b * 2048 + cc * 128 + 2 * lane) * NPROJ + 3328; ng0 = bf2f(gp[h]); ng1 = bf2f(gp[4 + h]); ng2 = bf2f(gp[NPROJ + h]); ng3 = bf2f(gp[NPROJ + 4 + h]); }
    };
    auto gate_scan = [&](int cc) {
        float* V = vecs + (cc & 1) * 640; const int l0 = 2 * lane;
        const float gi0 = ng0 + bi_, gf0 = ng1 + bf_, gi1 = ng2 + bi_, gf1 = ng3 + bf_;
        const float lf0 = logsigf_(gf0), lf1 = logsigf_(gf1);
        float sc = lf0 + lf1;
#pragma unroll
        for (int o = 1; o < 64; o <<= 1) { const float t = __shfl_up(sc, o); if (lane >= o) sc += t; }
        const float b0 = sc - lf1, b1 = sc, g0 = gi0 - b0, g1 = gi1 - b1;
        float mx = fmaxf(g0, g1);
#pragma unroll
        for (int o = 1; o < 64; o <<= 1) { const float t = __shfl_up(mx, o); if (lane >= o) mx = fmaxf(mx, t); }
        float pv = __shfl_up(mx, 1); if (lane == 0) pv = -3.0e38f;
        const float M0 = fmaxf(mprev, fmaxf(pv, g0)), M1 = fmaxf(mprev, mx);
        V[l0] = __expf(mprev - M0); V[l0 + 1] = __expf(mprev - M1);
        V[128 + l0] = __expf(-(b0 + M0)); V[128 + l0 + 1] = __expf(-(b1 + M1));
        V[256 + l0] = g0; V[256 + l0 + 1] = g1; V[384 + l0] = M0; V[384 + l0 + 1] = M1;
        const float M127 = __shfl(M1, 63), b127 = __shfl(b1, 63);
        V[512 + l0] = __expf(g0 - M127); V[512 + l0 + 1] = __expf(g1 - M127);
        mprev = b127 + M127;
    };
    issue_chunk(0);
    if (ML && wid == 5) gate_scan(0);
    for (int c = 0; c < 16; ++c) {
        const int tok0 = b * 2048 + c * 128;
        float* V = vecs + (ML ? (c & 1) * 640 : 0);
        float* wst = V; float* emt = V + 128; float* gvec = V + 256; float* Mvec = V + 384; float* wl = V + 512;
        u32x2 owr[4], gwr[4];
        { const bf16_t* rowp = proj + (size_t)(tok0 + 32 * lt + (lane >> 3)) * NPROJ + 32 * et + 4 * (lane & 7);
#pragma unroll
          for (int i = 0; i < 4; ++i) { owr[i] = ML ? *(const u32x2*)(rowp + (size_t)(8 * i) * NPROJ + OOFF) : (u32x2){0u, 0u}; gwr[i] = *(const u32x2*)(rowp + (size_t)(8 * i) * NPROJ + GOFF); } }
        bf16_t* stgC = Ks + wid * 1152;
        bf16_t* stgD = Ps + wid * 1152;
        if (ML && tid < 128) den[tid] = 0.f;
        {
            const int d8 = pd8;
            const u32x4 q1 = nq1, q2 = nq2, k1 = nk1, k2 = nk2, v1 = nv1, v2 = nv2;
            float qa[8], qb[8], ka[8], kb[8]; unpack8(q1, qa); unpack8(q2, qb); unpack8(k1, ka); unpack8(k2, kb);
            if (!ML) {
#pragma unroll
                for (int j = 0; j < 8; ++j) { const float co = ncs[j >> 1][(j & 1) * 2], si = ncs[j >> 1][(j & 1) * 2 + 1];
                    const float x1 = qa[j], x2 = qb[j]; qa[j] = x1 * co - x2 * si; qb[j] = x1 * si + x2 * co;
                    const float y1 = ka[j], y2 = kb[j]; ka[j] = y1 * co - y2 * si; kb[j] = y1 * si + y2 * co; }
            }
#pragma unroll
            for (int j = 0; j < 8; ++j) { ka[j] *= 0.125f; kb[j] *= 0.125f; }
            *(u32x4*)(Qs + ql * 72 + 8 * qc) = pack8(qa); *(u32x4*)(Qs + ql * 72 + 32 + 8 * qc) = pack8(qb);
            *(u32x4*)(Ks + ql * 72 + 8 * qc) = pack8(ka); *(u32x4*)(Ks + ql * 72 + 32 + 8 * qc) = pack8(kb);
            const unsigned vv1[4] = {v1.x, v1.y, v1.z, v1.w}, vv2[4] = {v2.x, v2.y, v2.z, v2.w};
#pragma unroll
            for (int j = 0; j < 4; ++j) {
                Vt[(8 * d8 + 2 * j) * 136 + pl] = (bf16_t)(vv1[j] & 0xffffu); Vt[(8 * d8 + 2 * j + 1) * 136 + pl] = (bf16_t)(vv1[j] >> 16);
                Vt[(32 + 8 * d8 + 2 * j) * 136 + pl] = (bf16_t)(vv2[j] & 0xffffu); Vt[(32 + 8 * d8 + 2 * j + 1) * 136 + pl] = (bf16_t)(vv2[j] >> 16); }
            if (c < 15) issue_chunk(c + 1);
        }
        __syncthreads();
        const float wsl = ML ? wst[127] : exp2f(lg2 * 128.0f);
        {
            const float Ml = ML ? Mvec[l] : 0.f; float dsum = 0.f;
#pragma unroll
            for (int mi = 0; mi < 2; ++mi) {
                const int mt = 2 * (wid & 1) + mi;
                if (mt <= lt) {
                    f32x16 acc;
#pragma unroll
                    for (int i = 0; i < 16; ++i) acc[i] = 0.f;
#pragma unroll
                    for (int ks = 0; ks < 4; ++ks) { const bf16x8 af = *(const bf16x8*)(Ks + (32 * mt + r) * 72 + 16 * ks + 8 * hh), bq = *(const bf16x8*)(Qs + l * 72 + 16 * ks + 8 * hh); acc = mfma32(af, bq, acc); }
#pragma unroll
                    for (int q = 0; q < 4; ++q) { float pv[4];
#pragma unroll
                        for (int j = 0; j < 4; ++j) { const int m = 32 * mt + 8 * q + 4 * hh + j;
                            float w;
                            if (ML) w = __expf(fminf(gvec[m] - Ml, 0.f)); else w = exp2f(lg2 * (float)max(l - m, 0));
                            w = (m <= l) ? w : 0.f;
                            pv[j] = acc[4 * q + j] * w; dsum += pv[j]; }
                        u32x2 o; o.x = pk2(pv[0], pv[1]); o.y = pk2(pv[2], pv[3]); *(u32x2*)(Ps + l * 136 + 32 * mt + 8 * q + 4 * hh) = o; }
                }
            }
            if (ML) { dsum += __shfl_xor(dsum, 32); if (hh == 0) atomicAdd(&den[l], dsum); }
            { const int m = tid & 127, dq = tid >> 7; const float w = wl[m];
              const u32x4 k1 = *(const u32x4*)(Ks + m * 72 + 16 * dq), k2 = *(const u32x4*)(Ks + m * 72 + 16 * dq + 8);
              float ka[8], kb[8]; unpack8(k1, ka); unpack8(k2, kb);
#pragma unroll
              for (int j = 0; j < 8; ++j) { Kwt[(16 * dq + j) * 136 + m] = f2bf(ka[j] * w); Kwt[(16 * dq + 8 + j) * 136 + m] = f2bf(kb[j] * w); } }
            if (ML && tid < 128) { float sacc = 0.f; const float* nv = nvec + cur * 64;
#pragma unroll
                for (int d8 = 0; d8 < 8; ++d8) { float qv[8]; unpack8(*(const u32x4*)(Qs + tid * 72 + 8 * d8), qv);
#pragma unroll
                    for (int j = 0; j < 8; ++j) sacc += qv[j] * nv[8 * d8 + j]; }
                dst[tid] = sacc; }
        }
        __syncthreads();
        f32x16 acc;
        {
#pragma unroll
            for (int i = 0; i < 16; ++i) acc[i] = 0.f;
            const bf16_t* Tc = Tt + cur * 64 * 72;
#pragma unroll
            for (int ks = 0; ks < 4; ++ks) { const bf16x8 af = *(const bf16x8*)(Tc + (32 * et + r) * 72 + 16 * ks + 8 * hh), bq = *(const bf16x8*)(Qs + l * 72 + 16 * ks + 8 * hh); acc = mfma32(af, bq, acc); }
            const float ws_ = wst[l];
#pragma unroll
            for (int i = 0; i < 16; ++i) acc[i] *= ws_;
            for (int ks = 0; ks < 2 * (lt + 1); ++ks) { const bf16x8 af = *(const bf16x8*)(Vt + (32 * et + r) * 136 + 16 * ks + 8 * hh), bp = *(const bf16x8*)(Ps + l * 136 + 16 * ks + 8 * hh); acc = mfma32(af, bp, acc); }
            if (ML) {
                const float dn = den[l] + ws_ * dst[l]; const float sc = 1.0f / fmaxf(fabsf(dn), emt[l]);
#pragma unroll
                for (int i = 0; i < 4; ++i) *(u32x2*)(stgC + ((lane >> 3) + 8 * i) * 36 + 4 * (lane & 7)) = owr[i];
                wave_lds_fence();
#pragma unroll
                for (int q = 0; q < 4; ++q) { const u32x2 ow = *(const u32x2*)(stgC + r * 36 + 8 * q + 4 * hh);
                    acc[4 * q + 0] *= sc * sigmoidf_(bflo(ow.x)); acc[4 * q + 1] *= sc * sigmoidf_(bfhi(ow.x));
                    acc[4 * q + 2] *= sc * sigmoidf_(bflo(ow.y)); acc[4 * q + 3] *= sc * sigmoidf_(bfhi(ow.y)); }
            }
            float s1 = 0.f, s2 = 0.f;
#pragma unroll
            for (int i = 0; i < 16; ++i) { s1 += acc[i]; s2 += acc[i] * acc[i]; }
            s1 += __shfl_xor(s1, 32); s2 += __shfl_xor(s2, 32);
            if (hh == 0) *(f32x2*)(stat + (et * 128 + l) * 2) = (f32x2){s1, s2};
        }
        if (wid < 4) {
            const int et2 = wid >> 1, dt2 = wid & 1;
#pragma unroll
            for (int i = 0; i < 16; ++i) accT[i] *= wsl;
#pragma unroll
            for (int ks = 0; ks < 8; ++ks) { const bf16x8 af = *(const bf16x8*)(Vt + (32 * et2 + r) * 136 + 16 * ks + 8 * hh), bk = *(const bf16x8*)(Kwt + (32 * dt2 + r) * 136 + 16 * ks + 8 * hh); accT = mfma32(af, bk, accT); }
            bf16_t* Tn = Tt + (cur ^ 1) * 64 * 72;
#pragma unroll
            for (int i = 0; i < 16; ++i) Tn[(32 * et2 + (i & 3) + 8 * (i >> 2) + 4 * hh) * 72 + 32 * dt2 + r] = f2bf(accT[i]);
        } else if (ML && wid == 4) {
            float sacc = 0.f;
#pragma unroll
            for (int m8 = 0; m8 < 16; ++m8) { float kv[8]; unpack8(*(const u32x4*)(Kwt + lane * 136 + 8 * m8), kv);
#pragma unroll
                for (int j = 0; j < 8; ++j) sacc += kv[j]; }
            nvec[(cur ^ 1) * 64 + lane] = wsl * nvec[cur * 64 + lane] + sacc;
        } else if (ML && wid == 5 && c < 15) gate_scan(c + 1);
        __syncthreads();
        {
            const f32x2 sa = *(const f32x2*)(stat + l * 2), sb = *(const f32x2*)(stat + (128 + l) * 2);
            const float mu = (sa[0] + sb[0]) * (1.0f / 64.0f), var = fmaxf((sa[1] + sb[1]) * (1.0f / 64.0f) - mu * mu, 0.f), rs = rsqrtf(var + EPS);
#pragma unroll
            for (int i = 0; i < 4; ++i) *(u32x2*)(stgD + ((lane >> 3) + 8 * i) * 36 + 4 * (lane & 7)) = gwr[i];
            wave_lds_fence();
            u32x2 wv[4];
#pragma unroll
            for (int q = 0; q < 4; ++q) { const u32x2 g2 = *(const u32x2*)(stgD + r * 36 + 8 * q + 4 * hh);
                wv[q].x = pk2((acc[4 * q] - mu) * rs * gnl[q][0] * siluf_(bflo(g2.x)), (acc[4 * q + 1] - mu) * rs * gnl[q][1] * siluf_(bfhi(g2.x)));
                wv[q].y = pk2((acc[4 * q + 2] - mu) * rs * gnl[q][2] * siluf_(bflo(g2.y)), (acc[4 * q + 3] - mu) * rs * gnl[q][3] * siluf_(bfhi(g2.y))); }
            wave_lds_fence();
#pragma unroll
            for (int q = 0; q < 4; ++q) *(u32x2*)(stgD + r * 36 + 8 * q + 4 * hh) = wv[q];
            wave_lds_fence();
            bf16_t* mp = MIX + (size_t)(tok0 + 32 * lt + (lane >> 3)) * 1024 + MIXOFF + 32 * et + 4 * (lane & 7);
#pragma unroll
            for (int i = 0; i < 4; ++i) *(u32x2*)(mp + (size_t)(8 * i) * 1024) = *(const u32x2*)(stgD + ((lane >> 3) + 8 * i) * 36 + 4 * (lane & 7));
        }
        cur ^= 1;
    }
    __syncthreads();
    const size_t sidx = (size_t)((layer * 8 + b) * 4 + h);
    if (wid < 4) { const int et2 = wid >> 1, dt2 = wid & 1; float* so = a.out + (ML ? O_MLCP : O_RETP) + sidx * 4096;
#pragma unroll
        for (int i = 0; i < 16; ++i) { const int e = 32 * et2 + (i & 3) + 8 * (i >> 2) + 4 * hh, d = 32 * dt2 + r; if (ML) so[e * 64 + d] = accT[i]; else so[d * 64 + e] = accT[i]; } }
    if (ML) { if (wid == 4) a.out[O_MLNP + sidx * 64 + lane] = nvec[cur * 64 + lane]; if (wid == 5 && lane == 0) a.out[O_MLMP + sidx] = mprev; }
}

DI void s5_prompt(const int tid, CArgs& a, int layer, int b, int g, unsigned char* sm) {
    const int wid = tid >> 6, lane = tid & 63, fr = lane & 15, fq = lane >> 4;
    float* buf = (float*)sm + wid * 16 * 132; float* Ew = (float*)(sm + 8 * 16 * 132 * 4);
    const bf16_t* proj = (const bf16_t*)(a.ws + W_PROJ); bf16_t* SY = (bf16_t*)(a.ws + W_SY);
    const int lgi = layer * 16 + g;
    const f32x2 ab = ((const f32x2*)(a.ws + W_ABAR))[lgi * 64 + lane];
    const bf16_t* bbm = (const bf16_t*)(a.ws + W_BBM) + (size_t)lgi * 128 * 16; const bf16_t* cm = (const bf16_t*)(a.ws + W_CM) + (size_t)lgi * 16 * 128;
    const bf16x8 zero8 = {0, 0, 0, 0, 0, 0, 0, 0};
    bf16x8 bbf[8], cf[4];
#pragma unroll
    for (int nt = 0; nt < 8; ++nt) bbf[nt] = lane < 32 ? *(const bf16x8*)(bbm + (16 * nt + fr) * 16 + 8 * fq) : zero8;
#pragma unroll
    for (int ks = 0; ks < 4; ++ks) cf[ks] = *(const bf16x8*)(cm + fr * 128 + 32 * ks + 8 * fq);
    const float dsk = a.in[I_S5D][layer * 256 + g * 16 + fr];
    const int tok0 = b * 2048 + 256 * wid;
    float xr = 0.f, xi = 0.f;
    const bf16_t* ubase = proj + (size_t)tok0 * NPROJ + 2304 + g * 16;
    for (int pass = 0; pass < 2; ++pass) {
        bf16x8 uf_n = lane < 32 ? *(const bf16x8*)(ubase + (size_t)fr * NPROJ + 8 * (fq & 1)) : zero8;
        bf16_t u4_n[4];
#pragma unroll
        for (int i = 0; i < 4; ++i) u4_n[i] = pass == 1 ? ubase[(size_t)(4 * fq + i) * NPROJ + fr] : (bf16_t)0;
        for (int it = 0; it < 16; ++it) {
            const bf16x8 uf = uf_n; bf16_t u4[4];
#pragma unroll
            for (int i = 0; i < 4; ++i) u4[i] = u4_n[i];
            if (it < 15) {
                uf_n = lane < 32 ? *(const bf16x8*)(ubase + (size_t)(16 * (it + 1) + fr) * NPROJ + 8 * (fq & 1)) : zero8;
                if (pass == 1) {
#pragma unroll
                    for (int i = 0; i < 4; ++i) u4_n[i] = ubase[(size_t)(16 * (it + 1) + 4 * fq + i) * NPROJ + fr]; }
            }
#pragma unroll
            for (int nt = 0; nt < 8; ++nt) { f32x4 z = {0.f, 0.f, 0.f, 0.f}; z = mfma16(uf, bbf[nt], z);
#pragma unroll
                for (int i = 0; i < 4; ++i) buf[(4 * fq + i) * 132 + 16 * nt + fr] = z[i]; }
            wave_lds_fence();
#pragma unroll
            for (int t = 0; t < 16; ++t) { const float br = buf[t * 132 + lane], bi = buf[t * 132 + 64 + lane];
                const float nr = ab.x * xr - ab.y * xi + br, ni = ab.x * xi + ab.y * xr + bi; xr = nr; xi = ni;
                if (pass == 1) { buf[t * 132 + lane] = xr; buf[t * 132 + 64 + lane] = xi; } }
            if (pass == 1) {
                wave_lds_fence();
                f32x4 y = {0.f, 0.f, 0.f, 0.f};
#pragma unroll
                for (int ks = 0; ks < 4; ++ks) { const f32x4 x0 = *(const f32x4*)(buf + fr * 132 + 32 * ks + 8 * fq), x1 = *(const f32x4*)(buf + fr * 132 + 32 * ks + 8 * fq + 4);
                    u32x4 w; w.x = pk2(x0[0], x0[1]); w.y = pk2(x0[2], x0[3]); w.z = pk2(x1[0], x1[1]); w.w = pk2(x1[2], x1[3]);
                    y = mfma16(__builtin_bit_cast(bf16x8, w), cf[ks], y); }
#pragma unroll
                for (int i = 0; i < 4; ++i) { const size_t trow = (size_t)(tok0 + 16 * it + 4 * fq + i);
                    SY[trow * 256 + g * 16 + fr] = f2bf(gelu_tanh(y[i] + dsk * bf2f(u4[i]))); }
            }
            wave_lds_fence();
        }
        if (pass == 0) {
            Ew[wid * 128 + lane] = xr; Ew[wid * 128 + 64 + lane] = xi;
            __syncthreads();
            float pr = ab.x, pi = ab.y;
#pragma unroll
            for (int s = 0; s < 8; ++s) { const float nr = pr * pr - pi * pi, ni = 2.f * pr * pi; pr = nr; pi = ni; }
            xr = 0.f; xi = 0.f;
            for (int j = 0; j < wid; ++j) { const float er = Ew[j * 128 + lane], ei = Ew[j * 128 + 64 + lane]; const float nr = pr * xr - pi * xi + er, ni = pr * xi + pi * xr + ei; xr = nr; xi = ni; }
        }
    }
    if (wid == 7) { const size_t o = (size_t)((layer * 8 + b) * 16 + g) * 64 + lane; a.out[O_S5RP + o] = xr; a.out[O_S5IP + o] = xi; }
}

DI void xattn_prompt(const int tid, CArgs& a, int layer, int b, int h, int qt, unsigned char* sm) {
    const int wid = tid >> 6, lane = tid & 63, r = lane & 31, hh = lane >> 5;
    bf16_t* Kx = (bf16_t*)sm; bf16_t* Vxt = (bf16_t*)(sm + 36864);
    const float* mk = a.out + O_MEMK + (size_t)(layer * 8 + b) * 65536 + h * 64; const float* mv = a.out + O_MEMV + (size_t)(layer * 8 + b) * 65536 + h * 64;
    const bf16_t* proj = (const bf16_t*)(a.ws + W_PROJ); bf16_t* MIX = (bf16_t*)(a.ws + W_MIX);
#pragma unroll
    for (int i = 0; i < 8; ++i) { const int idx = i * 512 + tid; { const int m = idx >> 4, d4 = idx & 15; const f32x4 v = *(const f32x4*)(mk + (size_t)m * 256 + 4 * d4); u32x2 w; w.x = pk2(v[0], v[1]); w.y = pk2(v[2], v[3]); *(u32x2*)(Kx + m * 72 + 4 * d4) = w; }
        { const int m = idx & 255, d4 = idx >> 8; const f32x4 v = *(const f32x4*)(mv + (size_t)m * 256 + 4 * d4);
#pragma unroll
          for (int j = 0; j < 4; ++j) Vxt[(4 * d4 + j) * 264 + m] = f2bf(v[j]); } }
    __syncthreads();
    const size_t trow = (size_t)b * 2048 + qt * 256 + 32 * wid + r;
    bf16x8 qf[4];
#pragma unroll
    for (int ks = 0; ks < 4; ++ks) qf[ks] = *(const bf16x8*)(proj + trow * NPROJ + 2816 + h * 64 + 16 * ks + 8 * hh);
    f32x16 acc[8];
#pragma unroll
    for (int mt = 0; mt < 8; ++mt) {
#pragma unroll
        for (int i = 0; i < 16; ++i) acc[mt][i] = 0.f;
#pragma unroll
        for (int ks = 0; ks < 4; ++ks) { const bf16x8 af = *(const bf16x8*)(Kx + (32 * mt + r) * 72 + 16 * ks + 8 * hh); acc[mt] = mfma32(af, qf[ks], acc[mt]); }
    }
    float mx = -3.0e38f;
#pragma unroll
    for (int mt = 0; mt < 8; ++mt)
#pragma unroll
        for (int i = 0; i < 16; ++i) mx = fmaxf(mx, acc[mt][i]);
    mx = fmaxf(mx, __shfl_xor(mx, 32));
    float sum = 0.f;
#pragma unroll
    for (int mt = 0; mt < 8; ++mt)
#pragma unroll
        for (int i = 0; i < 16; ++i) { const float p = exp2f((acc[mt][i] - mx) * (0.125f * 1.4426950408889634f)); acc[mt][i] = p; sum += p; }
    sum += __shfl_xor(sum, 32);
    f32x16 o[2];
#pragma unroll
    for (int et = 0; et < 2; ++et)
#pragma unroll
        for (int i = 0; i < 16; ++i) o[et][i] = 0.f;
#pragma unroll
    for (int mt = 0; mt < 8; ++mt)
#pragma unroll
        for (int s = 0; s < 2; ++s) {
            u32x4 pw; pw.x = pk2(acc[mt][8 * s], acc[mt][8 * s + 1]); pw.y = pk2(acc[mt][8 * s + 2], acc[mt][8 * s + 3]); pw.z = pk2(acc[mt][8 * s + 4], acc[mt][8 * s + 5]); pw.w = pk2(acc[mt][8 * s + 6], acc[mt][8 * s + 7]);
            const bf16x8 pb = __builtin_bit_cast(bf16x8, pw);
#pragma unroll
            for (int et = 0; et < 2; ++et) { const bf16_t* vp = Vxt + (32 * et + r) * 264 + 32 * mt + 16 * s + 4 * hh;
                const u32x2 lo = *(const u32x2*)vp, hi = *(const u32x2*)(vp + 8); u32x4 aw; aw.x = lo.x; aw.y = lo.y; aw.z = hi.x; aw.w = hi.y;
                o[et] = mfma32(__builtin_bit_cast(bf16x8, aw), pb, o[et]); }
        }
    const float inv = 1.0f / sum;
#pragma unroll
    for (int et = 0; et < 2; ++et)
#pragma unroll
        for (int q = 0; q < 4; ++q) { const int e0 = 32 * et + 8 * q + 4 * hh; const u32x2 gw = *(const u32x2*)(proj + trow * NPROJ + 3072 + h * 64 + e0);
            u32x2 w; w.x = pk2(o[et][4 * q] * inv * siluf_(bflo(gw.x)), o[et][4 * q + 1] * inv * siluf_(bfhi(gw.x))); w.y = pk2(o[et][4 * q + 2] * inv * siluf_(bflo(gw.y)), o[et][4 * q + 3] * inv * siluf_(bfhi(gw.y)));
            *(u32x2*)(MIX + trow * 1024 + 768 + h * 64 + e0) = w; }
}

DI void ret_sample(const int tid, CArgs& a, int layer, int id) {
    const int lane = tid & 63, b = id >> 2, h = id & 3;
    const bf16_t* prow = (const bf16_t*)(a.ws + W_PROJ) + (size_t)(MP + b) * NPROJ; const float* rope = (const float*)(a.ws + W_ROPE) + (size_t)2048 * 64;
    const float co = rope[2 * (lane & 31)], si = rope[2 * (lane & 31) + 1];
    float q = bf2f(prow[h * 64 + lane]), k = bf2f(prow[256 + h * 64 + lane]); const float v = bf2f(prow[512 + h * 64 + lane]);
    { const float qp = __shfl_xor(q, 32), kp = __shfl_xor(k, 32); q = lane < 32 ? q * co - qp * si : qp * si + q * co; k = (lane < 32 ? k * co - kp * si : kp * si + k * co) * 0.125f; }
    const float qk = wave_sum(q * k), gam = 1.0f - exp2f(-5.0f - (float)h);
    const size_t sidx = (size_t)((layer * 128 + b) * 4 + h) * 4096;
    const float* S0 = a.in[I_SRET] + sidx; float* So = a.out + O_RETS + sidx;
    const int sub = lane >> 4, e4 = lane & 15;
    f32x4 v4; v4[0] = __shfl(v, 4 * e4); v4[1] = __shfl(v, 4 * e4 + 1); v4[2] = __shfl(v, 4 * e4 + 2); v4[3] = __shfl(v, 4 * e4 + 3);
    f32x4 acc = {0.f, 0.f, 0.f, 0.f};
#pragma unroll 4
    for (int it = 0; it < 16; ++it) { const int d = 4 * it + sub; const f32x4 s4 = *(const f32x4*)(S0 + d * 64 + 4 * e4); const float qd = __shfl(q, d), kd = __shfl(k, d);
        acc += qd * s4; *(f32x4*)(So + d * 64 + 4 * e4) = gam * s4 + kd * v4; }
#pragma unroll
    for (int j = 0; j < 4; ++j) { acc[j] += __shfl_xor(acc[j], 16); acc[j] += __shfl_xor(acc[j], 32); }
    f32x4 o = qk * v4 + gam * acc;
    float s = o[0] + o[1] + o[2] + o[3]; s += __shfl_xor(s, 1); s += __shfl_xor(s, 2); s += __shfl_xor(s, 4); s += __shfl_xor(s, 8); const float mu = s * (1.0f / 64.0f);
    o -= mu; float q2 = o[0] * o[0] + o[1] * o[1] + o[2] * o[2] + o[3] * o[3]; q2 += __shfl_xor(q2, 1); q2 += __shfl_xor(q2, 2); q2 += __shfl_xor(q2, 4); q2 += __shfl_xor(q2, 8);
    const float rs = rsqrtf(q2 * (1.0f / 64.0f) + EPS);
    if (sub == 0) { const float* gn = a.in[I_RGN] + layer * 256 + h * 64 + 4 * e4; const u32x2 gw = *(const u32x2*)(prow + 768 + h * 64 + 4 * e4);
        u32x2 w; w.x = pk2(o[0] * rs * gn[0] * siluf_(bflo(gw.x)), o[1] * rs * gn[1] * siluf_(bfhi(gw.x))); w.y = pk2(o[2] * rs * gn[2] * siluf_(bflo(gw.y)), o[3] * rs * gn[3] * siluf_(bfhi(gw.y)));
        *(u32x2*)((bf16_t*)(a.ws + W_MIX) + (size_t)(MP + b) * 1024 + h * 64 + 4 * e4) = w; }
}
DI void mlstm_sample(const int tid, CArgs& a, int layer, int id) {
    const int lane = tid & 63, b = id >> 2, h = id & 3;
    const bf16_t* prow = (const bf16_t*)(a.ws + W_PROJ) + (size_t)(MP + b) * NPROJ; const float gp[8] = {bf2f(prow[3328]), bf2f(prow[3329]), bf2f(prow[3330]), bf2f(prow[3331]), bf2f(prow[3332]), bf2f(prow[3333]), bf2f(prow[3334]), bf2f(prow[3335])};
    const float q = bf2f(prow[1024 + h * 64 + lane]), k = bf2f(prow[1280 + h * 64 + lane]) * 0.125f, v = bf2f(prow[1536 + h * 64 + lane]), mo = bf2f(prow[1792 + h * 64 + lane]), mg = bf2f(prow[2048 + h * 64 + lane]);
    const float gi = gp[h] + a.in[I_BI][layer * 4 + h], lf = logsigf_(gp[4 + h] + a.in[I_BF][layer * 4 + h]);
    const size_t hidx = (size_t)((layer * 128 + b) * 4 + h);
    const float m0 = a.in[I_SM][hidx], aa = lf + m0, mt = fmaxf(aa, gi), wi = __expf(gi - mt), wsx = __expf(aa - mt);
    const float s = wave_sum(q * k) * wi; const float n0 = a.in[I_SN][hidx * 64 + lane]; const float den = s + wsx * wave_sum(n0 * q);
    const float sc = 1.0f / fmaxf(fabsf(den), __expf(-mt));
    const float* C0 = a.in[I_SC] + hidx * 4096; float* Co = a.out + O_MLCS + hidx * 4096;
    const int sub = lane >> 4, d4 = lane & 15;
    f32x4 q4, k4;
#pragma unroll
    for (int j = 0; j < 4; ++j) { q4[j] = __shfl(q, 4 * d4 + j); k4[j] = __shfl(k, 4 * d4 + j); }
    float hv[16]; float hs = 0.f;
#pragma unroll
    for (int it = 0; it < 16; ++it) { const int e = 4 * it + sub; const f32x4 c4 = *(const f32x4*)(C0 + e * 64 + 4 * d4);
        float dot = c4[0] * q4[0] + c4[1] * q4[1] + c4[2] * q4[2] + c4[3] * q4[3]; dot += __shfl_xor(dot, 1); dot += __shfl_xor(dot, 2); dot += __shfl_xor(dot, 4); dot += __shfl_xor(dot, 8);
        const float ve = __shfl(v, e), moe = __shfl(mo, e);
        *(f32x4*)(Co + e * 64 + 4 * d4) = wsx * c4 + (wi * ve) * k4;
        hv[it] = (s * ve + wsx * dot) * sc * sigmoidf_(moe); hs += hv[it]; }
    hs += __shfl_xor(hs, 16); hs += __shfl_xor(hs, 32); const float mu = hs * (1.0f / 64.0f);
    float q2 = 0.f;
#pragma unroll
    for (int it = 0; it < 16; ++it) { hv[it] -= mu; q2 += hv[it] * hv[it]; }
    q2 += __shfl_xor(q2, 16); q2 += __shfl_xor(q2, 32); const float rs = rsqrtf(q2 * (1.0f / 64.0f) + EPS);
    const float* gn = a.in[I_MGN] + layer * 256 + h * 64; bf16_t* mp = (bf16_t*)(a.ws + W_MIX) + (size_t)(MP + b) * 1024 + 256 + h * 64;
#pragma unroll
    for (int it = 0; it < 16; ++it) { const int e = 4 * it + sub; const float g = __shfl(mg, e); if (d4 == 0) mp[e] = f2bf(hv[it] * rs * gn[e] * siluf_(g)); }
    a.out[O_MLNS + hidx * 64 + lane] = wsx * n0 + wi * k;
    if (lane == 0) a.out[O_MLMS + hidx] = mt;
}
DI void s5_sample(const int tid, CArgs& a, int layer, int id) {
    const int lane = tid & 63, b = id >> 4, g = id & 15, lgi = layer * 16 + g;
    const bf16_t* prow = (const bf16_t*)(a.ws + W_PROJ) + (size_t)(MP + b) * NPROJ;
    const float uu = bf2f(prow[2304 + g * 16 + (lane & 15)]);
    const size_t sidx = (size_t)((layer * 128 + b) * 16 + g) * 64 + lane;
    const float x0r = a.in[I_S5R][sidx], x0i = a.in[I_S5I][sidx];
    const f32x2 ab = ((const f32x2*)(a.ws + W_ABAR))[lgi * 64 + lane];
    const f32x4* bb = (const f32x4*)((const f32x2*)(a.ws + W_BBF) + (size_t)(lgi * 64 + lane) * 16);
    float bur = 0.f, bui = 0.f;
#pragma unroll
    for (int c2 = 0; c2 < 8; ++c2) { const f32x4 w = bb[c2]; const float u0 = __shfl(uu, 2 * c2), u1 = __shfl(uu, 2 * c2 + 1); bur += w[0] * u0 + w[2] * u1; bui += w[1] * u0 + w[3] * u1; }
    const float xr = ab.x * x0r - ab.y * x0i + bur, xi = ab.x * x0i + ab.y * x0r + bui;
    a.out[O_S5RS + sidx] = xr; a.out[O_S5IS + sidx] = xi;
    float y = 0.f;
#pragma unroll
    for (int ch = 0; ch < 16; ++ch) { const size_t ci = ((size_t)lgi * 16 + ch) * 64 + lane; const float t = wave_sum(a.in[I_CRE][ci] * xr - a.in[I_CIM][ci] * xi); if (lane == ch) y = t; }
    if (lane < 16) { y += a.in[I_S5D][layer * 256 + g * 16 + lane] * uu; ((bf16_t*)(a.ws + W_SY))[(size_t)(MP + b) * 256 + g * 16 + lane] = f2bf(gelu_tanh(y)); }
}
DI void xattn_sample(const int tid, CArgs& a, int layer, int b, unsigned char* sm) {
    const int wid = tid >> 6, lane = tid & 63, hd = lane >> 4, j16 = lane & 15;
    float* sc = (float*)sm; float* po = sc + 1024;
    const bf16_t* prow = (const bf16_t*)(a.ws + W_PROJ) + (size_t)(MP + b) * NPROJ;
    const u32x2 qw = *(const u32x2*)(prow + 2816 + 4 * lane); const f32x4 q4 = {bflo(qw.x), bfhi(qw.x), bflo(qw.y), bfhi(qw.y)};
    const float* Kc = a.in[I_CK] + (size_t)(layer * 128 + b) * 65536 + 4 * lane; const float* Vc = a.in[I_CV] + (size_t)(layer * 128 + b) * 65536 + 4 * lane;
#pragma unroll 16
    for (int i = 0; i < 32; ++i) { const int m = 32 * wid + i; const f32x4 k4 = *(const f32x4*)(Kc + (size_t)m * 256);
        float dot = k4[0] * q4[0] + k4[1] * q4[1] + k4[2] * q4[2] + k4[3] * q4[3]; dot += __shfl_xor(dot, 1); dot += __shfl_xor(dot, 2); dot += __shfl_xor(dot, 4); dot += __shfl_xor(dot, 8);
        if (j16 == 0) sc[hd * 256 + m] = dot * 0.125f; }
    __syncthreads();
    float mx = -3.0e38f;
#pragma unroll
    for (int t = 0; t < 16; ++t) mx = fmaxf(mx, sc[hd * 256 + j16 + 16 * t]);
    mx = fmaxf(mx, __shfl_xor(mx, 1)); mx = fmaxf(mx, __shfl_xor(mx, 2)); mx = fmaxf(mx, __shfl_xor(mx, 4)); mx = fmaxf(mx, __shfl_xor(mx, 8));
    float sum = 0.f;
#pragma unroll
    for (int t = 0; t < 16; ++t) sum += __expf(sc[hd * 256 + j16 + 16 * t] - mx);
    sum += __shfl_xor(sum, 1); sum += __shfl_xor(sum, 2); sum += __shfl_xor(sum, 4); sum += __shfl_xor(sum, 8);
    const float inv = 1.0f / sum;
    f32x4 acc = {0.f, 0.f, 0.f, 0.f};
#pragma unroll 16
    for (int i = 0; i < 32; ++i) { const int m = 32 * wid + i; const f32x4 v4 = *(const f32x4*)(Vc + (size_t)m * 256); const float p = __expf(sc[hd * 256 + m] - mx) * inv; acc += p * v4; }
    *(f32x4*)(po + wid * 256 + 4 * lane) = acc;
    __syncthreads();
    if (tid < 256) { float o = 0.f;
#pragma unroll
        for (int w = 0; w < 8; ++w) o += po[w * 256 + tid];
        ((bf16_t*)(a.ws + W_MIX))[(size_t)(MP + b) * 1024 + 768 + tid] = f2bf(o * siluf_(bf2f(prow[3072 + tid]))); }
}

DI void task_done(const int tid, unsigned* dep) {
    asm volatile("s_waitcnt vmcnt(0)" ::: "memory");
    __syncthreads();
    if (tid == 0) { __threadfence(); __hip_atomic_fetch_add(dep, 1u, __ATOMIC_RELAXED, __HIP_MEMORY_SCOPE_AGENT); }
}
DI void glu_task(const int tid, CArgs& a, int layer, int pm, unsigned* dep0, unsigned char* sm) {
    if (tid == 0) {
        unsigned* dep = dep0 + 16 * (pm < 64 ? (pm >> 3) : 8); const unsigned need = pm < 64 ? 16u : 256u; unsigned sp = 0;
        while (__hip_atomic_load(dep, __ATOMIC_RELAXED, __HIP_MEMORY_SCOPE_AGENT) < need && ++sp < (1u << 22)) __builtin_amdgcn_s_sleep(2);
        __threadfence();
    }
    __syncthreads();
    unsigned char* ws = a.ws;
    pg8::Gemm g; pg8::Epi E; g.ready = nullptr; g.need = 0; g.gate_pm = -1;
    g.A = (const bf16_t*)(ws + W_SY); g.Bt = (const bf16_t*)(ws + W_WGLUT) + (size_t)layer * 65536; g.M = MPAD; g.N = 256; g.K = 256;
    E.mode = 2; E.O = (bf16_t*)(ws + W_MIX); E.SY = (const bf16_t*)(ws + W_SY); E.PROJ = (const bf16_t*)(ws + W_PROJ); E.out = a.out; E.src = a.out; E.xbuf = nullptr; E.pcnt = nullptr; E.nw = nullptr; E.XNo = nullptr;
    pg8::StaticOrder S; S.init_single(pm);
    pg8::gemm_phase(tid, (LAS unsigned char*)sm, g, S, E);
}
DI void phase_mixers(CArgs& a, int layer, unsigned char* sm) {
    unsigned* ctr = (unsigned*)(a.ws + W_CTL) + 16 * layer;
    unsigned* dep0 = (unsigned*)(a.ws + W_CTL) + 256 + 160 * layer;
    volatile int* slot = (volatile int*)(sm + LDS_CTL);
    for (;;) {
        int tid = threadIdx.x; asm volatile("" : "+v"(tid)); const int wid = tid >> 6;
        __syncthreads();
        if (tid == 0) *slot = (int)atomicAdd(ctr, 1u);
        __syncthreads();
        const int t = *slot;
        if (t >= (layer == 0 ? 1311 : 1025)) break;
        if (t < 32) seq_mixer<false>(tid, a, layer, t >> 2, t & 3, sm);
        else if (t < 64) seq_mixer<true>(tid, a, layer, (t - 32) >> 2, (t - 32) & 3, sm);
        else if (t < 192) { s5_prompt(tid, a, layer, (t - 64) >> 4, (t - 64) & 15, sm); task_done(tid, dep0 + 16 * ((t - 64) >> 4)); }
        else if (t < 448) { s5_sample(tid, a, layer, (t - 192) * 8 + wid); task_done(tid, dep0 + 16 * 8); }
        else if (t < 576) xattn_sample(tid, a, layer, t - 448, sm);
        else if (t < 832) { const int u = t - 576; xattn_prompt(tid, a, layer, u >> 5, (u >> 3) & 3, u & 7, sm); }
        else if (t < 897) glu_task(tid, a, layer, t - 832, dep0, sm);
        else if (t < 961) ret_sample(tid, a, layer, (t - 897) * 8 + wid);
        else if (t < 1025) mlstm_sample(tid, a, layer, (t - 961) * 8 + wid);
        else prep_task(tid, a, t - 1025, sm);
    }
}

DI void outproj_sample(const int tid, CArgs& a, int layer, const float* src) {
    const int wid = tid >> 6, lane = tid & 63, fr = lane & 15, fq = lane >> 4;
    const bf16_t* A = (const bf16_t*)(a.ws + W_MIX) + (size_t)MP * 1024; const bf16_t* Bt = (const bf16_t*)(a.ws + W_WOUTT) + (size_t)layer * 1024 * 1024;
    for (int t = blockIdx.x * 8 + wid; t < 512; t += gridDim.x * 8) {
        const int mi = t >> 6, ni = t & 63; f32x4 acc = {0.f, 0.f, 0.f, 0.f};
        const bf16_t* ap = A + (size_t)(16 * mi + fr) * 1024 + 8 * fq; const bf16_t* bp = Bt + (size_t)(16 * ni + fr) * 1024 + 8 * fq;
#pragma unroll 8
        for (int ks = 0; ks < 32; ++ks) acc = mfma16(*(const bf16x8*)(ap + 32 * ks), *(const bf16x8*)(bp + 32 * ks), acc);
#pragma unroll
        for (int i = 0; i < 4; ++i) { const size_t row = (size_t)(16 * mi + 4 * fq + i), col = (size_t)(16 * ni + fr); a.out[O_YS + row * 1024 + col] = src[row * 1024 + col] + acc[i]; }
    }
}

#define XB_TMO      128
#define XB_XCNT(j)  (256  + 64 * (j))
#define XB_XSUB(j)  (1280 + 64 * (j))
#define XB_XGEN(j)  (2304 + 64 * (j))
#define XB_TOP      3328
#define XB_TOPGEN   3392
#define XCD_BAR_WORDS 3456
#define XB_SPIN_CAP (1u << 18)
DI unsigned xb_ld(unsigned* p)              { return __hip_atomic_load(p, __ATOMIC_RELAXED, __HIP_MEMORY_SCOPE_AGENT); }
DI unsigned xb_add(unsigned* p, unsigned v) { return __hip_atomic_fetch_add(p, v, __ATOMIC_RELAXED, __HIP_MEMORY_SCOPE_AGENT); }
DI unsigned xb_xcc_id() { return (unsigned)__builtin_amdgcn_s_getreg((3 << 11) | 20) & 0xFu; }
#define XB_SPIN(cond, bar) do { unsigned _sp = 0; while (cond) { __builtin_amdgcn_s_sleep(1); \
    if ((++_sp & 255u) == 0u) { if (xb_ld(&(bar)[XB_TMO])) break; if (_sp > XB_SPIN_CAP) { atomicAdd(&(bar)[XB_TMO], 1u); break; } } } } while (0)
struct XcdBarrier { unsigned* bar; unsigned x; volatile LAS unsigned* st; };
DI XcdBarrier xcd_barrier_post(unsigned* bar, volatile LAS unsigned* st) {
    XcdBarrier b; b.bar = bar; b.x = xb_xcc_id(); b.st = st;
    if (threadIdx.x == 0) (void)xb_add(&bar[XB_XCNT(b.x)], 1u);
    return b;
}
DI void xcd_barrier_complete(unsigned* bar, unsigned x, unsigned& nloc, unsigned& nx) {
    const unsigned G = gridDim.x * gridDim.y * gridDim.z;
    unsigned sum, cnt, mine, sp = 0u;
    for (;;) {
        sum = 0u; cnt = 0u; mine = 0u;
#pragma unroll
        for (unsigned j = 0; j < 16; ++j) { const unsigned c = xb_ld(&bar[XB_XCNT(j)]); sum += c; cnt += (c > 0u) ? 1u : 0u; mine = (j == x) ? c : mine; }
        if (sum == G) break;
        __builtin_amdgcn_s_sleep(1);
        if ((++sp & 255u) == 0u) { if (xb_ld(&bar[XB_TMO])) break; if (sp > XB_SPIN_CAP) { atomicAdd(&bar[XB_TMO], 1u); break; } }
    }
    nloc = mine > 0u ? mine : 1u; nx = cnt > 0u ? cnt : 1u;
}
DI void xcd_barrier(const XcdBarrier& b) {
    asm volatile("s_waitcnt vmcnt(0)" ::: "memory");
    __syncthreads();
    if (threadIdx.x == 0) {
        unsigned* bar = b.bar;
        __builtin_amdgcn_s_waitcnt(0);
        unsigned nloc = b.st[0], nx = b.st[1];
        if (nloc == 0u) { xcd_barrier_complete(bar, b.x, nloc, nx); b.st[0] = nloc; b.st[1] = nx; }
        const unsigned old = xb_add(&bar[XB_XSUB(b.x)], 1u);
        const unsigned gen = old / nloc;
        if (old + 1u == (gen + 1u) * nloc) {
            __builtin_amdgcn_fence(__ATOMIC_RELEASE, "agent");
            asm volatile("s_waitcnt vmcnt(0)" ::: "memory");
            const unsigned og = xb_add(&bar[XB_TOP], 1u);
            const unsigned tg = og / nx;
            if (og + 1u == (tg + 1u) * nx) xb_add(&bar[XB_TOPGEN], 1u);
            else XB_SPIN(xb_ld(&bar[XB_TOPGEN]) == tg, bar);
            __builtin_amdgcn_fence(__ATOMIC_ACQUIRE, "agent");
            xb_add(&bar[XB_XGEN(b.x)], 1u);
            asm volatile("s_waitcnt vmcnt(0)" ::: "memory");
        } else {
            XB_SPIN(xb_ld(&bar[XB_XGEN(b.x)]) == gen, bar);
            __builtin_amdgcn_fence(__ATOMIC_ACQUIRE, "agent");
            asm volatile("s_waitcnt vmcnt(0)" ::: "memory");
        }
    }
    __syncthreads();
}
DI void seam(unsigned char* shm) {
    CArgs* kp = (CArgs*)__builtin_amdgcn_kernarg_segment_ptr(); asm volatile("" : "+s"(kp));
    XcdBarrier b; b.bar = (unsigned*)(kp->ws + W_BAR); b.x = xb_xcc_id(); b.st = (volatile LAS unsigned*)(LAS unsigned char*)(shm + LDS_CTL + 16);
    xcd_barrier(b);
}

#ifndef FUSE_PRE
#define FUSE_PRE 1
#endif
constexpr int NPH = 9;
template <int ph>
DI void run_phase(unsigned char* shm) {
    LAS unsigned char* lds = (LAS unsigned char*)shm;
    const int G = (int)gridDim.x, bid = (int)blockIdx.x;
    constexpr int layer = ph >= 4 ? 1 : 0;
    int tid = threadIdx.x; asm volatile("" : "+v"(tid));
    CArgs* kp = (CArgs*)__builtin_amdgcn_kernarg_segment_ptr(); asm volatile("" : "+s"(kp)); CArgs& a = *kp;
    unsigned char* ws = a.ws;
    if constexpr (ph == 0 || ph == 4) { if (ph == 0) phase_prep(tid, a, shm);
        phase_norm(tid, a, layer, ph ? a.out : a.in[I_XP], ph ? a.out + O_YS : a.in[I_XS], shm, !(ph == 4 && G == 256 && FUSE_PRE)); }
    else if constexpr (ph == 2 || ph == 6) phase_mixers(a, layer, shm);
    else if constexpr (ph == 8) phase_final_norm(tid, a);
    else {
        constexpr int nsub = ph == 1 ? 2 : 1;
        const bool gate5 = ph == 5 && G == 256 && FUSE_PRE;
        unsigned* depX = (unsigned*)(ws + W_CTL) + 672;
        if (gate5 && bid >= G - 16) { norm_sample_rows(tid, a, 1, a.out + O_YS); task_done(tid, depX); }
        for (int sub = 0; sub < nsub; ++sub) {
            pg8::Gemm g; pg8::Epi E; int c = bid; g.ready = nullptr; g.need = 0; g.gate_pm = -1;
            E.O = (bf16_t*)(ws + W_PROJ); E.SY = (const bf16_t*)(ws + W_SY); E.PROJ = (const bf16_t*)(ws + W_PROJ); E.out = a.out; E.src = a.out;
            E.xbuf = (float*)(ws + (ph == 3 ? W_XB2 : W_XB)); E.pcnt = (unsigned*)(ws + W_PCNT) + (ph == 3 ? 1024 : 0); E.nw = ph == 3 ? a.in[I_NW] + 1024 : a.in[I_FNW]; E.XNo = (bf16_t*)(ws + W_XN);
            if (ph == 1 || ph == 5) {
                if (sub == 0) { g.A = (const bf16_t*)(ws + W_XN); g.Bt = (const bf16_t*)(ws + W_WINT) + (size_t)layer * NPROJ * 1024; g.M = MPAD; g.N = NPROJ; g.K = 1024; E.mode = 0; if (gate5) { g.ready = depX; g.need = 16u; g.gate_pm = 64; } }
                else { g.A = (const bf16_t*)(ws + W_MEMB); g.Bt = (const bf16_t*)(ws + W_WMEMT); g.M = 2048; g.N = 1024; g.K = 1024; E.mode = 1; c = G - 1 - bid; }
            } else { g.A = (const bf16_t*)(ws + W_MIX); g.Bt = (const bf16_t*)(ws + W_WOUTT) + (size_t)layer * 1024 * 1024; g.M = MP; g.N = 1024; g.K = 1024; E.mode = G == 256 ? (ph == 7 ? 4 : (FUSE_PRE ? 5 : 3)) : 3; E.src = layer ? a.out : a.in[I_XP]; }
            pg8::StaticOrder S; S.init(g.M, g.N, G, c);
            pg8::gemm_phase(tid, lds, g, S, E);
        }
        if (ph == 1) { const int blo = G == 256 ? 142 : 0, bhi = G == 256 ? 224 : G;
            if (bid >= blo && bid < bhi)
#pragma unroll 1
            for (int j = bid - blo; j < 272; j += bhi - blo) prep_tile(tid, a, j < 256 ? 1920 + j : 2448 + (j - 256), (float*)shm);
        }
        if (ph == 3 || ph == 7) outproj_sample(tid, a, layer, layer ? a.out + O_YS : a.in[I_XS]);
        if (G == 256 && ph == 7) {
            unsigned* depS = (unsigned*)(ws + W_CTL) + (ph == 3 ? 656 : 640);
            if (bid < 64) task_done(tid, depS);
            else if (bid < 192) {
                if (tid == 0) { unsigned sp = 0; while (__hip_atomic_load(depS, __ATOMIC_RELAXED, __HIP_MEMORY_SCOPE_AGENT) < 64u && ++sp < (1u << 22)) __builtin_amdgcn_s_sleep(2); __threadfence(); }
                __syncthreads();
                if (tid < 64) { float* p = a.out + O_YS + (size_t)(bid - 64) * 1024; const float* nw = ph == 3 ? a.in[I_NW] + 1024 : a.in[I_FNW]; f32x4 x[4]; float ss = 0.f;
#pragma unroll
                    for (int i = 0; i < 4; ++i) { x[i] = *(const f32x4*)(p + 256 * i + 4 * tid); ss += x[i][0] * x[i][0] + x[i][1] * x[i][1] + x[i][2] * x[i][2] + x[i][3] * x[i][3]; }
                    ss = wave_sum(ss); const float rstd = rsqrtf(ss * (1.0f / 1024.0f) + EPS);
#pragma unroll
                    for (int i = 0; i < 4; ++i) { const f32x4 w = *(const f32x4*)(nw + 256 * i + 4 * tid); const f32x4 y = x[i] * rstd * w;
                        if (ph == 7) *(f32x4*)(p + 256 * i + 4 * tid) = y;
                        else { u32x2 o; o.x = pk2(y[0], y[1]); o.y = pk2(y[2], y[3]); *(u32x2*)((bf16_t*)(ws + W_XN) + (size_t)(MP + bid - 64) * 1024 + 256 * i + 4 * tid) = o; } } }
            }
        }
    }
}

__global__ __launch_bounds__(512, 2) void mk_fwd(Args a_) {
    extern __shared__ __attribute__((aligned(16))) unsigned char shm[];
    cg::grid_group grid = cg::this_grid();
    const int lo = a_.ph_lo, hi = a_.ph_hi;
    if (hi - lo > 1) {
        if (threadIdx.x < 4) ((volatile LAS unsigned*)(LAS unsigned char*)(shm + LDS_CTL + 16))[threadIdx.x] = 0u;
        __syncthreads();
        CArgs* kp = (CArgs*)__builtin_amdgcn_kernarg_segment_ptr();
        (void)xcd_barrier_post((unsigned*)(kp->ws + W_BAR), (volatile LAS unsigned*)(LAS unsigned char*)(shm + LDS_CTL + 16));
    }
    if (hi > 1000) grid.sync();
#define RUN_PHASE(P) if (P >= lo && P < hi) { run_phase<P>(shm); if (P + 1 < hi) seam(shm); }
    const bool fusedn = gridDim.x == 256 && lo == 0 && hi == NPH;
    RUN_PHASE(0) RUN_PHASE(1) RUN_PHASE(2)
    RUN_PHASE(3)
    if (!(fusedn && FUSE_PRE)) { RUN_PHASE(4) }
    RUN_PHASE(5) RUN_PHASE(6)
    if (fusedn) { run_phase<7>(shm); } else { RUN_PHASE(7) RUN_PHASE(8) }
#undef RUN_PHASE
}

#ifndef N_LAUNCH_PER_PHASE
#define N_LAUNCH_PER_PHASE 0
#endif
extern "C" void kernel_launch(void* const* d_in, const int* in_sizes, int n_in, void* d_out, int out_size, void* d_ws, size_t ws_size, hipStream_t stream) {
    static int grid = 0;
    if (grid == 0) {
        if (n_in != 30 || ws_size < W_END) { fprintf(stderr, "kernel_launch: unexpected n_in %d / ws %zu (need %zu)\n", n_in, ws_size, (size_t)W_END); grid = -1; return; }
        int dev = 0, cus = 0, per_cu = 0;
        hipGetDevice(&dev); hipDeviceGetAttribute(&cus, hipDeviceAttributeMultiprocessorCount, dev);
        if (hipFuncSetAttribute((const void*)mk_fwd, hipFuncAttributeMaxDynamicSharedMemorySize, LDS_BYTES) != hipSuccess) { fprintf(stderr, "kernel_launch: hipFuncSetAttribute failed\n"); grid = -1; return; }
        if (hipOccupancyMaxActiveBlocksPerMultiprocessor(&per_cu, (const void*)mk_fwd, 512, LDS_BYTES) != hipSuccess || per_cu < 1) { fprintf(stderr, "kernel_launch: occupancy query says %d\n", per_cu); per_cu = 1; }
        (void)hipGetLastError();
        grid = cus * per_cu;
    }
    if (grid < 0) return;
    if (hipMemsetAsync(d_ws, 0, W_WINT, stream) != hipSuccess) { fprintf(stderr, "kernel_launch: hipMemsetAsync failed\n"); return; }
    Args a{};
    for (int i = 0; i < 30; ++i) a.in[i] = (const float*)d_in[i];
    a.out = (float*)d_out; a.ws = (unsigned char*)d_ws;
#if N_LAUNCH_PER_PHASE
    for (int ph = 0; ph < NPH; ++ph) { if (grid == 256 && (ph == 4 || ph == 8)) continue; a.ph_lo = ph; a.ph_hi = ph + 1; hipLaunchKernelGGL(mk_fwd, dim3(grid), dim3(512), LDS_BYTES, stream, a); }
#else
    a.ph_lo = 0; a.ph_hi = NPH;
    void* args[] = {&a};
    hipError_t e = hipLaunchCooperativeKernel((const void*)mk_fwd, dim3(grid), dim3(512), args, LDS_BYTES, stream);
    if (e != hipSuccess) fprintf(stderr, "cooperative launch failed: %s (grid %d)\n", hipGetErrorString(e), grid);
#endif
}
```

```cpp
#include <hip/hip_runtime.h>
#include <hip/hip_cooperative_groups.h>
#include <cstdio>
#include <cstdint>
namespace cg = cooperative_groups;

#define DI __device__ __forceinline__
#define LAS __attribute__((address_space(3)))
typedef unsigned short bf16_t;
typedef short bf16x8 __attribute__((ext_vector_type(8)));
typedef float f32x4 __attribute__((ext_vector_type(4)));
typedef float f32x2 __attribute__((ext_vector_type(2)));
typedef float f32x16 __attribute__((ext_vector_type(16)));
typedef unsigned u32x4 __attribute__((ext_vector_type(4)));
typedef unsigned u32x2 __attribute__((ext_vector_type(2)));
typedef __bf16 bfv2 __attribute__((ext_vector_type(2)));

constexpr int D = 1024, MP = 16384, MS = 128, MT = MP + MS, MPAD = 16640, NPROJ = 3584  , DIN = 3336;
constexpr int LDS_BYTES = 148480, LDS_CTL = 147456;
constexpr float EPS = 1e-6f;
constexpr size_t O_YP = 0, O_YS = 16777216, O_RETP = O_YS + 131072, O_RETS = O_RETP + 262144, O_MLCP = O_RETS + 4194304,
                 O_MLCS = O_MLCP + 262144, O_MLNP = O_MLCS + 4194304, O_MLNS = O_MLNP + 4096, O_MLMP = O_MLNS + 65536,
                 O_MLMS = O_MLMP + 64, O_S5RP = O_MLMS + 1024, O_S5RS = O_S5RP + 16384, O_S5IP = O_S5RS + 262144,
                 O_S5IS = O_S5IP + 16384, O_MEMK = O_S5IS + 262144, O_MEMV = O_MEMK + 1048576;
constexpr size_t W_CTL = 0, W_BAR = 4096, W_PCNT = 20480  , W_WINT = 32768, W_WOUTT = W_WINT + 2ull * NPROJ * 1024 * 2, W_WMEMT = W_WOUTT + 2ull * 1024 * 1024 * 2,
                 W_WGLUT = W_WMEMT + 1024ull * 1024 * 2, W_MEMB = W_WGLUT + 2ull * 256 * 256 * 2, W_ROPE = W_MEMB + 2048ull * 1024 * 2,
                 W_ABAR = W_ROPE + 2049ull * 32 * 2 * 4 + 256, W_BBF = W_ABAR + 2ull * 16 * 64 * 2 * 4, W_BBM = W_BBF + 2ull * 16 * 64 * 16 * 2 * 4,
                 W_CM = W_BBM + 2ull * 16 * 128 * 16 * 2, W_XN = W_CM + 2ull * 16 * 16 * 128 * 2, W_GATES = W_XN + (size_t)MPAD * 1024 * 2,
                 W_PROJ = W_GATES + (size_t)MT * 8 * 4, W_SY = W_PROJ + (size_t)MPAD * NPROJ * 2, W_MIX = W_SY + (size_t)MPAD * 256 * 2,
                 W_XB = W_MIX + (size_t)MPAD * 1024 * 2,
                 W_XB2 = W_XB + 16384ull * 4 * 4,
                 W_END = W_XB2 + 16384ull * 4 * 4;

struct Args { const float* in[30]; float* out; unsigned char* ws; int ph_lo, ph_hi; };
typedef const Args __attribute__((address_space(4))) CArgs;
enum { I_XP = 0, I_XS, I_MEM, I_SRET, I_SC, I_SN, I_SM, I_S5R, I_S5I, I_CK, I_CV, I_NW, I_WIN, I_RGN, I_BI, I_BF, I_MGN,
       I_ARE, I_AIM, I_LDT, I_BRE, I_BIM, I_CRE, I_CIM, I_S5D, I_WGLU, I_WMK, I_WMV, I_WOUT, I_FNW };

DI unsigned pk2(float lo, float hi) { f32x2 v = {lo, hi}; bfv2 r = __builtin_convertvector(v, bfv2); return __builtin_bit_cast(unsigned, r); }
DI bf16_t f2bf(float f) { return (bf16_t)(pk2(f, 0.f) & 0xffffu); }
DI float bf2f(bf16_t b) { return __uint_as_float(((unsigned)b) << 16); }
DI float bflo(unsigned w) { return __uint_as_float(w << 16); }
DI float bfhi(unsigned w) { return __uint_as_float(w & 0xffff0000u); }
DI float wave_sum(float v) { for (int o = 32; o > 0; o >>= 1) v += __shfl_xor(v, o); return v; }
DI float sigmoidf_(float x) { return 1.0f / (1.0f + __expf(-x)); }
DI float siluf_(float x) { return x / (1.0f + __expf(-x)); }
DI float gelu_tanh(float y) { const float z = 0.7978845608028654f * (y + 0.044715f * y * y * y); const float t = 1.0f - 2.0f / (1.0f + __expf(2.0f * z)); return 0.5f * y * (1.0f + t); }
DI float logsigf_(float x) { return fminf(x, 0.f) - log1pf(__expf(-fabsf(x))); }
DI f32x16 mfma32(bf16x8 a, bf16x8 b, f32x16 c) { return __builtin_amdgcn_mfma_f32_32x32x16_bf16(a, b, c, 0, 0, 0); }
DI f32x4 mfma16(bf16x8 a, bf16x8 b, f32x4 c) { return __builtin_amdgcn_mfma_f32_16x16x32_bf16(a, b, c, 0, 0, 0); }
DI void unpack8(u32x4 w, float (&f)[8]) { f[0] = bflo(w.x); f[1] = bfhi(w.x); f[2] = bflo(w.y); f[3] = bfhi(w.y); f[4] = bflo(w.z); f[5] = bfhi(w.z); f[6] = bflo(w.w); f[7] = bfhi(w.w); }
DI u32x4 pack8(const float (&f)[8]) { u32x4 w; w.x = pk2(f[0], f[1]); w.y = pk2(f[2], f[3]); w.z = pk2(f[4], f[5]); w.w = pk2(f[6], f[7]); return w; }
DI void wave_lds_fence() { asm volatile("" ::: "memory"); __builtin_amdgcn_wave_barrier(); asm volatile("s_waitcnt lgkmcnt(0)" ::: "memory"); }
DI void sincos_f(float a, float& s, float& c) {
    const float n = rintf(a * 0.15915494309189535f);
    float r = fmaf(-n, 6.2831854820251465f, a); r = fmaf(-n, -1.7484555e-7f, r);
    const float x = r * 0.25f, x2 = x * x;
    const float sp = x * (1.0f + x2 * (-1.6666667e-1f + x2 * (8.3333333e-3f + x2 * (-1.9841270e-4f + x2 * 2.7557319e-6f))));
    const float cp = 1.0f + x2 * (-0.5f + x2 * (4.1666667e-2f + x2 * (-1.3888889e-3f + x2 * (2.4801587e-5f + x2 * -2.7557319e-7f))));
    const float s2 = 2.0f * sp * cp, c2 = 1.0f - 2.0f * sp * sp;
    s = 2.0f * s2 * c2; c = 1.0f - 2.0f * s2 * s2;
}

namespace pg8 {
constexpr int BM = 256, BK = 64, HALF = 128, HTB = HALF * BK * 2, STAGE_BYTES = 8 * HTB, NXCD = 8, WGM = 8;
__host__ __device__ __forceinline__ int lds_byte(int r, int c) { const int st = (r >> 4) * 2 + (c >> 5), rr = r & 15, cc = c & 31, ob = rr * 64 + cc * 2; return st * 1024 + (ob ^ (((ob >> 9) & 1) << 5)); }
__host__ __device__ __forceinline__ void stage_rc(int b, int& R, int& C) { const int st = b / 1024, sb = b % 1024, swz = sb ^ (((sb >> 9) & 1) << 5); R = (st >> 1) * 16 + swz / 64; C = (st & 1) * 32 + (swz % 64) / 2; }
__host__ __device__ __forceinline__ int perm32(int rho) { const int n = rho >> 4, i = rho & 15; return 8 * (i >> 2) + 4 * n + (i & 3); }
struct Unit { int pm, pn; };
struct Gemm { const bf16_t* A; const bf16_t* Bt; int M, N, K; const unsigned* ready; unsigned need; int gate_pm; };
struct StaticOrder {
    int nM, nN, nwg, G, c, direct;
    __device__ void init(int M, int N, int G_, int c_) { nM = M / BM; nN = N / BM; nwg = nM * nN; G = G_; c = c_; direct = 0; }
    __device__ void init_single(int pm) { nM = nN = nwg = G = 1; c = pm; direct = 1; }
    __device__ bool next(int i, Unit& u) const {
        if (direct) { if (i) return false; u.pm = c; u.pn = 0; return true; }
        const long L = (long)i * G + c; if (L >= nwg) return false;
        int wgid = (int)L; { const int q = nwg / NXCD, r = nwg % NXCD, xcd = wgid % NXCD, off = wgid / NXCD; wgid = (xcd < r ? xcd * (q + 1) : r * (q + 1) + (xcd - r) * q) + off; }
        const int nig = WGM * nN, gid = wgid / nig, fm = gid * WGM, gsz = (nM - fm) < WGM ? (nM - fm) : WGM;
        u.pm = fm + ((wgid % nig) % gsz); u.pn = (wgid % nig) / gsz; return true;
    }
};
struct Epi {
    int mode; bf16_t* O; const bf16_t* SY; const bf16_t* PROJ; float* out; const float* src;
    float* xbuf; unsigned* pcnt; const float* nw; bf16_t* XNo;
    DI bool perm() const { return mode == 0 || mode == 2; }
    DI void fused(f32x4 (&acc)[2][2][4][2], const Unit& u, int wr, int wc, int fr, int fq, LAS unsigned char* lds, int wid, int lane) const {
        LAS float* P = (LAS float*)lds; LAS float* S = (LAS float*)(lds + 4096);
        const int rloc = wr * 64 + fr, col0 = u.pn * BM + wc * 32 + 4 * fq;
#pragma unroll
        for (int ai = 0; ai < 2; ++ai)
#pragma unroll
            for (int m = 0; m < 4; ++m) { const size_t o = (size_t)(u.pm * BM + rloc + ai * HALF + m * 16) * 1024 + col0; float ss = 0.f;
#pragma unroll
                for (int bj = 0; bj < 2; ++bj)
#pragma unroll
                    for (int n = 0; n < 2; ++n) { const f32x4 sv = *(const f32x4*)(src + o + bj * HALF + n * 16); const f32x4 x = acc[ai][bj][m][n] + sv; acc[ai][bj][m][n] = x;
                        ss += (x[0] * x[0] + x[1] * x[1]) + (x[2] * x[2] + x[3] * x[3]); }
                ss += __shfl_xor(ss, 16); ss += __shfl_xor(ss, 32);
                if (fq == 0) P[(rloc + ai * HALF + m * 16) * 4 + wc] = ss;
                if (m & 1) __builtin_amdgcn_sched_barrier(0); }
        asm volatile("s_waitcnt lgkmcnt(0)" ::: "memory"); __builtin_amdgcn_s_barrier(); asm volatile("" ::: "memory");
        const int row = wid * 32 + (lane & 31);
        if (lane < 32) { const float t = (P[row * 4] + P[row * 4 + 1]) + (P[row * 4 + 2] + P[row * 4 + 3]);
            __hip_atomic_store(xbuf + (size_t)(u.pm * BM + row) * 4 + u.pn, t, __ATOMIC_RELAXED, __HIP_MEMORY_SCOPE_AGENT); }
        asm volatile("s_waitcnt vmcnt(0)" ::: "memory");
        if (lane == 0) __hip_atomic_fetch_add(pcnt + 16 * u.pm, 1u, __ATOMIC_RELAXED, __HIP_MEMORY_SCOPE_AGENT);
        if (wid == 0) {
            unsigned sp = 0;
            while ((unsigned)__builtin_amdgcn_readfirstlane(__hip_atomic_load(pcnt + 16 * u.pm, __ATOMIC_RELAXED, __HIP_MEMORY_SCOPE_AGENT)) < 32u && ++sp < (1u << 22)) __builtin_amdgcn_s_sleep(2);
            __builtin_amdgcn_fence(__ATOMIC_ACQUIRE, "agent");
        }
        asm volatile("s_waitcnt vmcnt(0) lgkmcnt(0)" ::: "memory"); __builtin_amdgcn_s_barrier(); asm volatile("" ::: "memory");
        if (lane < 32) { const float* slot = xbuf + (size_t)(u.pm * BM + row) * 4; float q = 0.f;
#pragma unroll
            for (int t = 0; t < 4; ++t) q += __hip_atomic_load(slot + t, __ATOMIC_RELAXED, __HIP_MEMORY_SCOPE_AGENT);
            S[row] = rsqrtf(q * (1.0f / 1024.0f) + EPS); }
        asm volatile("s_waitcnt lgkmcnt(0)" ::: "memory"); __builtin_amdgcn_s_barrier(); asm volatile("" ::: "memory");
#pragma unroll
        for (int ai = 0; ai < 2; ++ai)
#pragma unroll
            for (int m = 0; m < 4; ++m) { const size_t o = (size_t)(u.pm * BM + rloc + ai * HALF + m * 16) * 1024 + col0; const float rs = S[rloc + ai * HALF + m * 16];
#pragma unroll
                for (int bj = 0; bj < 2; ++bj)
#pragma unroll
                    for (int n = 0; n < 2; ++n) { const f32x4 w4 = *(const f32x4*)(nw + col0 + bj * HALF + n * 16); const f32x4 y = acc[ai][bj][m][n] * rs * w4;
                        if (mode == 4) *(f32x4*)(out + o + bj * HALF + n * 16) = y;
                        else { *(f32x4*)(out + o + bj * HALF + n * 16) = acc[ai][bj][m][n]; u32x2 w; w.x = pk2(y[0], y[1]); w.y = pk2(y[2], y[3]); *(u32x2*)(XNo + o + bj * HALF + n * 16) = w; } } }
    }
    DI void operator()(const f32x4 (&acc)[2][2][4][2], const Unit& u, int wr, int wc, int fr, int fq) const {
        const int row0 = u.pm * BM + wr * 64 + fr;
        if (mode == 0) {
            const int col0 = u.pn * BM + wc * 32 + 8 * fq;
#pragma unroll
            for (int ai = 0; ai < 2; ++ai)
#pragma unroll
                for (int m = 0; m < 4; ++m) { bf16_t* rowp = O + (size_t)(row0 + ai * HALF + m * 16) * NPROJ + col0;
#pragma unroll
                    for (int bj = 0; bj < 2; ++bj) { const f32x4 v0 = acc[ai][bj][m][0], v1 = acc[ai][bj][m][1];
                        u32x4 w; w.x = pk2(v0[0], v0[1]); w.y = pk2(v0[2], v0[3]); w.z = pk2(v1[0], v1[1]); w.w = pk2(v1[2], v1[3]);
                        *(u32x4*)(rowp + bj * HALF) = w; } }
        } else if (mode == 2) {
            const int col0 = wc * 32 + 8 * fq;
#pragma unroll
            for (int ai = 0; ai < 2; ++ai)
#pragma unroll
                for (int m = 0; m < 4; ++m) { const size_t row = (size_t)(row0 + ai * HALF + m * 16);
#pragma unroll
                    for (int bj = 0; bj < 2; ++bj) { const int col = col0 + bj * HALF;
                        const u32x4 syw = *(const u32x4*)(SY + row * 256 + col), sgw = *(const u32x4*)(PROJ + row * NPROJ + 2560 + col);
                        float sy[8], sg[8], o[8]; unpack8(syw, sy); unpack8(sgw, sg);
                        const f32x4 v0 = acc[ai][bj][m][0], v1 = acc[ai][bj][m][1];
#pragma unroll
                        for (int j = 0; j < 4; ++j) { o[j] = sy[j] * sigmoidf_(v0[j]) * siluf_(sg[j]); o[4 + j] = sy[4 + j] * sigmoidf_(v1[j]) * siluf_(sg[4 + j]); }
                        *(u32x4*)(O + row * 1024 + 512 + col) = pack8(o); }
                    if (m & 1) __builtin_amdgcn_sched_barrier(0); }
        } else if (mode == 1) {
            float* C = out + ((u.pn & 1) ? O_MEMV : O_MEMK) + (size_t)(u.pn >> 1) * 524288;
            const int col0 = wc * 32 + 4 * fq;
#pragma unroll
            for (int ai = 0; ai < 2; ++ai)
#pragma unroll
                for (int m = 0; m < 4; ++m) { float* rowp = C + (size_t)(row0 + ai * HALF + m * 16) * 256 + col0;
#pragma unroll
                    for (int bj = 0; bj < 2; ++bj)
#pragma unroll
                        for (int n = 0; n < 2; ++n) *(f32x4*)(rowp + bj * HALF + n * 16) = acc[ai][bj][m][n]; }
        } else {
            const int col0 = u.pn * BM + wc * 32 + 4 * fq;
#pragma unroll
            for (int ai = 0; ai < 2; ++ai)
#pragma unroll
                for (int m = 0; m < 4; ++m) { const size_t o = (size_t)(row0 + ai * HALF + m * 16) * 1024 + col0;
#pragma unroll
                    for (int bj = 0; bj < 2; ++bj)
#pragma unroll
                        for (int n = 0; n < 2; ++n) { const f32x4 sv = *(const f32x4*)(src + o + bj * HALF + n * 16); *(f32x4*)(out + o + bj * HALF + n * 16) = sv + acc[ai][bj][m][n]; }
                    if (m & 1) __builtin_amdgcn_sched_barrier(0); }
        }
    }
};

DI void a_ready_wait(const Gemm& g, int wid) {
    if (wid == 0) { unsigned sp = 0;
        while ((unsigned)__builtin_amdgcn_readfirstlane(__hip_atomic_load(g.ready, __ATOMIC_RELAXED, __HIP_MEMORY_SCOPE_AGENT)) < g.need && ++sp < (1u << 22)) __builtin_amdgcn_s_sleep(2);
        __builtin_amdgcn_fence(__ATOMIC_ACQUIRE, "agent");
        asm volatile("s_waitcnt vmcnt(0)" ::: "memory"); }
    asm volatile("" ::: "memory"); __builtin_amdgcn_s_barrier(); asm volatile("" ::: "memory");
}
DI void gemm_phase(const int tid, LAS unsigned char* lds, const Gemm g, const StaticOrder& S, const Epi& E) {
    const int wid = __builtin_amdgcn_readfirstlane(tid >> 6), lane = tid & 63, wr = wid >> 2, wc = wid & 3, fr = lane & 15, fq = lane >> 4;
    const int K = g.K, nt = K / BK;
    unsigned voffA[2], voffB[2];
#pragma unroll
    for (int i = 0; i < 2; ++i) { int R, C; stage_rc(tid * 16 + i * 8192, R, C); const int Rb = E.perm() ? ((R & ~31) + perm32(R & 31)) : R;
        voffA[i] = (unsigned)(R * K + C) * 2u; voffB[i] = (unsigned)(Rb * K + C) * 2u; }
    const size_t kstep = (size_t)(BK * 2);
    const size_t hstep = (size_t)HALF * K * 2;
    const size_t tstep = 2 * hstep;
    const unsigned ldsw = (unsigned)wid * 1024u;
    const int aoff = lds_byte(wr * 64 + fr, fq * 8), boff = lds_byte(wc * 32 + fr, fq * 8);
#define PG8_SA(b, h) (((b) * 2 + (h)) * HTB)
#define PG8_SB(b, h) ((4 + (b) * 2 + (h)) * HTB)
#define PG8_STAGE(bufoff, gbase, voff) do { _Pragma("unroll") for (int _i = 0; _i < 2; ++_i) \
        __builtin_amdgcn_global_load_lds((const unsigned*)((const char*)(gbase) + (voff)[_i]), (LAS unsigned*)(lds + (bufoff) + ldsw + _i * 8192), 16, 0, 0); } while (0)
#define PG8_LDA(dst, b, h) do { _Pragma("unroll") for (int m = 0; m < 4; ++m) _Pragma("unroll") for (int k = 0; k < 2; ++k) dst[m][k] = *(const LAS bf16x8*)(lds + PG8_SA(b, h) + aoff + m * 2048 + k * 1024); } while (0)
#define PG8_LDB(dst, b, h) do { _Pragma("unroll") for (int n = 0; n < 2; ++n) _Pragma("unroll") for (int k = 0; k < 2; ++k) dst[n][k] = *(const LAS bf16x8*)(lds + PG8_SB(b, h) + boff + n * 2048 + k * 1024); } while (0)
#define PG8_MMA(ai, bj, At, Bt) do { __builtin_amdgcn_s_setprio(1); _Pragma("unroll") for (int m = 0; m < 4; ++m) _Pragma("unroll") for (int n = 0; n < 2; ++n) _Pragma("unroll") for (int k = 0; k < 2; ++k) \
        acc[ai][bj][m][n] = __builtin_amdgcn_mfma_f32_16x16x32_bf16(Bt[n][k], At[m][k], acc[ai][bj][m][n], 0, 0, 0); __builtin_amdgcn_s_setprio(0); } while (0)
#define PG8_WAIT_V(n) asm volatile("s_waitcnt vmcnt(" #n ")" ::: "memory")
#define PG8_WAIT_L(n) asm volatile("s_waitcnt lgkmcnt(" #n ")" ::: "memory")
#define PG8_BAR __builtin_amdgcn_s_barrier()
#define PG8_SCHED __builtin_amdgcn_sched_barrier(0)
    Unit cur, nxt; int ui = 0;
    if (!S.next(0, cur)) return;
    f32x4 acc[2][2][4][2];
#pragma unroll
    for (int a = 0; a < 2; ++a)
#pragma unroll
        for (int b = 0; b < 2; ++b)
#pragma unroll
            for (int m = 0; m < 4; ++m)
#pragma unroll
                for (int n = 0; n < 2; ++n) acc[a][b][m][n] = (f32x4){0.f, 0.f, 0.f, 0.f};
    bf16x8 At[4][2], B0[2][2], B1[2][2];
    const char* cA = (const char*)g.A + (size_t)cur.pm * tstep; const char* cB = (const char*)g.Bt + (size_t)cur.pn * tstep;
    if (g.ready && cur.pm == g.gate_pm) a_ready_wait(g, wid);
    PG8_STAGE(PG8_SB(0, 0), cB, voffB); PG8_STAGE(PG8_SA(0, 0), cA, voffA); PG8_STAGE(PG8_SB(0, 1), cB + hstep, voffB); PG8_STAGE(PG8_SA(0, 1), cA + hstep, voffA);
    if (wr == 1) PG8_BAR;
    PG8_WAIT_V(4); PG8_BAR;
    PG8_STAGE(PG8_SB(1, 0), cB + kstep, voffB); PG8_STAGE(PG8_SA(1, 0), cA + kstep, voffA); PG8_STAGE(PG8_SB(1, 1), cB + hstep + kstep, voffB);
    PG8_WAIT_V(6); PG8_BAR;
    for (;;) {
        const bool has_next = S.next(ui + 1, nxt);
        const char* nA = has_next ? (const char*)g.A + (size_t)nxt.pm * tstep : cA; const char* nB = has_next ? (const char*)g.Bt + (size_t)nxt.pn * tstep : cB;
        for (int t = 0; t < nt; t += 2) {
            const bool last = (t == nt - 2);
            const char* a1 = cA + (size_t)(t + 1) * kstep;
            const char* a2 = last ? nA : cA + (size_t)(t + 2) * kstep; const char* b2 = last ? nB : cB + (size_t)(t + 2) * kstep;
            const char* a3 = a2 + kstep; const char* b3 = b2 + kstep;
            if (last && has_next && g.ready && nxt.pm == g.gate_pm) a_ready_wait(g, wid);
            PG8_LDB(B0, 0, 0); PG8_SCHED; PG8_LDA(At, 0, 0); PG8_STAGE(PG8_SA(1, 1), a1 + hstep, voffA);
            PG8_WAIT_L(8); PG8_BAR; PG8_WAIT_L(0); PG8_MMA(0, 0, At, B0); PG8_BAR; PG8_SCHED;
            PG8_LDB(B1, 0, 1); PG8_STAGE(PG8_SB(0, 0), b2, voffB);
            PG8_BAR; PG8_WAIT_L(0); PG8_MMA(0, 1, At, B1); PG8_BAR;
            PG8_LDA(At, 0, 1); PG8_STAGE(PG8_SA(0, 0), a2, voffA);
            PG8_BAR; PG8_WAIT_L(0); PG8_MMA(1, 0, At, B0); PG8_BAR; PG8_SCHED;
            PG8_STAGE(PG8_SB(0, 1), b2 + hstep, voffB);
            PG8_WAIT_V(6); PG8_BAR; PG8_MMA(1, 1, At, B1); PG8_BAR;
            PG8_LDB(B0, 1, 0); PG8_SCHED; PG8_LDA(At, 1, 0); PG8_STAGE(PG8_SA(0, 1), a2 + hstep, voffA);
            PG8_WAIT_L(8); PG8_BAR; PG8_WAIT_L(0); PG8_MMA(0, 0, At, B0); PG8_BAR; PG8_SCHED;
            PG8_LDB(B1, 1, 1); PG8_STAGE(PG8_SB(1, 0), b3, voffB);
            PG8_BAR; PG8_WAIT_L(0); PG8_MMA(0, 1, At, B1); PG8_BAR;
            PG8_LDA(At, 1, 1); PG8_STAGE(PG8_SA(1, 0), a3, voffA);
            PG8_BAR; PG8_WAIT_L(0); PG8_MMA(1, 0, At, B0); PG8_BAR; PG8_SCHED;
            PG8_STAGE(PG8_SB(1, 1), b3 + hstep, voffB);
            PG8_WAIT_V(6); PG8_BAR; PG8_MMA(1, 1, At, B1); PG8_BAR;
        }
        if (E.mode < 4) E(acc, cur, wr, wc, fr, fq);
        if (!has_next) break;
#pragma unroll
        for (int a = 0; a < 2; ++a)
#pragma unroll
            for (int b = 0; b < 2; ++b)
#pragma unroll
                for (int m = 0; m < 4; ++m)
#pragma unroll
                    for (int n = 0; n < 2; ++n) acc[a][b][m][n] = (f32x4){0.f, 0.f, 0.f, 0.f};
        cur = nxt; cA = nA; cB = nB; ++ui;
    }
    PG8_WAIT_V(0);
    if (wr == 0) PG8_BAR;
    PG8_BAR;
    if (E.mode >= 4) E.fused(acc, cur, wr, wc, fr, fq, lds, wid, lane);
#undef PG8_SA
#undef PG8_SB
#undef PG8_STAGE
#undef PG8_LDA
#undef PG8_LDB
#undef PG8_MMA
#undef PG8_WAIT_V
#undef PG8_WAIT_L
#undef PG8_BAR
#undef PG8_SCHED
}
}

DI void transpose_tile(const int tid, const float* src, int ld_src, int col0, int k0, bf16_t* dst, int n0, int K, float* tile) {
#pragma unroll
    for (int i = 0; i < 8; ++i) { const int kk = i * 8 + (tid >> 6), nn = tid & 63; tile[kk * 65 + nn] = src[(size_t)(k0 + kk) * ld_src + col0 + nn]; }
    __syncthreads();
#pragma unroll
    for (int i = 0; i < 8; ++i) { const int nn = i * 8 + (tid >> 6), kk = tid & 63; dst[(size_t)(n0 + nn) * K + k0 + kk] = f2bf(tile[kk * 65 + nn]); }
    __syncthreads();
}

DI void prep_tile(const int tid, CArgs& a, int t, float* tile) {
    unsigned char* ws = a.ws;
    if (t < 1664) { const int l = t / 832, r = t % 832, kt = r / 52, nt = r % 52; const int n0 = nt * 64;
        transpose_tile(tid, a.in[I_WIN] + (size_t)l * 1024 * DIN, DIN, n0 + (n0 >= 2304 ? 8 : 0), kt * 64, (bf16_t*)(ws + W_WINT) + (size_t)l * NPROJ * 1024, n0, 1024, tile); }
    else if (t < 2176) { const int u = t - 1664, l = u / 256, r = u % 256, kt = r / 16, nt = r % 16;
        transpose_tile(tid, a.in[I_WOUT] + (size_t)l * 1024 * 1024, 1024, nt * 64, kt * 64, (bf16_t*)(ws + W_WOUTT) + (size_t)l * 1024 * 1024, nt * 64, 1024, tile); }
    else if (t < 2432) { const int u = t - 2176, lk = u / 64, r = u % 64, kt = r / 4, nt = r % 4; const int l = lk >> 1, kv = lk & 1;
        transpose_tile(tid, a.in[kv ? I_WMV : I_WMK] + (size_t)l * 1024 * 256, 256, nt * 64, kt * 64, (bf16_t*)(ws + W_WMEMT) + (size_t)lk * 256 * 1024, nt * 64, 1024, tile); }
    else { const int u = t - 2432, l = u / 16, r = u % 16, kt = r / 4, nt = r % 4;
        transpose_tile(tid, a.in[I_WGLU] + (size_t)l * 65536, 256, nt * 64, kt * 64, (bf16_t*)(ws + W_WGLUT) + (size_t)l * 65536, nt * 64, 256, tile); }
}
DI void prep_gate_rows(CArgs& a, int i0, int iend, int stride, int l) {
    for (int i = i0; i < iend; i += stride) { const int n = i >> 10, k = i & 1023;
        ((bf16_t*)(a.ws + W_WINT))[((size_t)l * NPROJ + 3328 + n) * 1024 + k] = n < 8 ? f2bf(a.in[I_WIN][((size_t)l * 1024 + k) * DIN + 2304 + n]) : (bf16_t)0; }
}
DI void prep_task(const int tid, CArgs& a, int k, unsigned char* sm) {
    if (k < 416) {
#pragma unroll 1
        for (int j = 2 * k; j < 2 * k + 2; ++j) prep_tile(tid, a, 832 + j, (float*)sm);
    } else prep_gate_rows(a, (k - 416) * 32768 + tid, (k - 415) * 32768, 512, 1);
}
DI void phase_prep(const int tid, CArgs& a, unsigned char* sm) {
    const int nb = gridDim.x, bid = blockIdx.x;
    unsigned char* ws = a.ws;
    float* tile = (float*)sm;
#pragma unroll 1
    for (int t = bid; t < 1360; t += nb) prep_tile(tid, a, t < 832 ? t : (t < 1088 ? 1664 + (t - 832) : (t < 1344 ? 2176 + (t - 1088) : 2432 + (t - 1344))), tile);
    prep_gate_rows(a, bid * 512 + tid, 256 * 1024, nb * 512, 0);
    { const f32x4* src = (const f32x4*)a.in[I_MEM]; u32x2* dst = (u32x2*)(ws + W_MEMB);
#pragma unroll 2
      for (int i = bid * 512 + tid; i < 2048 * 1024 / 4; i += nb * 512) { const f32x4 v = src[i]; u32x2 w; w.x = pk2(v[0], v[1]); w.y = pk2(v[2], v[3]); dst[i] = w; } }
    { float* rope = (float*)(ws + W_ROPE);
#pragma unroll 1
      for (int i = bid * 512 + tid; i < 2049 * 32; i += nb * 512) { const int pr = i >> 5, j = i & 31; const float pos = pr == 2048 ? 16384.0f : (float)pr;
          const float inv = exp2f(-(float)j * (13.287712379549449f / 32.0f)); float sn, cs; sincos_f(pos * inv, sn, cs); rope[2 * i] = cs; rope[2 * i + 1] = sn; } }
#pragma unroll 1
    for (int i = bid * 512 + tid; i < 2048; i += nb * 512) {
        const int lg = i >> 6, p = i & 63;
        const float dt = __expf(a.in[I_LDT][lg]), are = a.in[I_ARE][i], aim = a.in[I_AIM][i];
        const float xx = are * dt, yy = aim * dt, ex1 = expm1f(xx), ex = ex1 + 1.0f;
        float sn, cs, sh, chh; sincos_f(yy, sn, cs); sincos_f(0.5f * yy, sh, chh);
        const float abr = ex * cs, abi = ex * sn, den = are * are + aim * aim, nr = ex1 - 2.0f * ex * sh * sh, ni = abi;
        const float fr = (nr * are + ni * aim) / den, fi = (ni * are - nr * aim) / den;
        ((f32x2*)(ws + W_ABAR))[i] = (f32x2){abr, abi};
        f32x2* bbf = (f32x2*)(ws + W_BBF) + (size_t)i * 16; bf16_t* bbm = (bf16_t*)(ws + W_BBM) + (size_t)lg * 128 * 16; bf16_t* cm = (bf16_t*)(ws + W_CM) + (size_t)lg * 16 * 128;
#pragma unroll 1
        for (int cc = 0; cc < 16; ++cc) { const float bre = a.in[I_BRE][(size_t)i * 16 + cc], bim = a.in[I_BIM][(size_t)i * 16 + cc];
            const float br = fr * bre - fi * bim, bi = fr * bim + fi * bre;
            bbf[cc] = (f32x2){br, bi}; bbm[p * 16 + cc] = f2bf(br); bbm[(64 + p) * 16 + cc] = f2bf(bi); }
#pragma unroll 1
        for (int ch = 0; ch < 16; ++ch) { cm[ch * 128 + p] = f2bf(a.in[I_CRE][((size_t)lg * 16 + ch) * 64 + p]); cm[ch * 128 + 64 + p] = f2bf(-a.in[I_CIM][((size_t)lg * 16 + ch) * 64 + p]); }
    }
}

DI void norm_sample_rows(const int tid, CArgs& a, int layer, const float* xs) {
    const int wid = tid >> 6, lane = tid & 63, j = ((int)blockIdx.x - ((int)gridDim.x - 16)) * 8 + wid;
    if (j < 0 || j >= MS) return;
    const float* nw = a.in[I_NW] + layer * 1024; const float* src = xs + (size_t)j * 1024; bf16_t* dst = (bf16_t*)(a.ws + W_XN) + (size_t)(MP + j) * 1024;
    f32x4 x[4]; float ss = 0.f;
#pragma unroll
    for (int i = 0; i < 4; ++i) { x[i] = *(const f32x4*)(src + 256 * i + 4 * lane); ss += x[i][0] * x[i][0] + x[i][1] * x[i][1] + x[i][2] * x[i][2] + x[i][3] * x[i][3]; }
    ss = wave_sum(ss); const float rstd = rsqrtf(ss * (1.0f / 1024.0f) + EPS);
#pragma unroll
    for (int i = 0; i < 4; ++i) { const int d0 = 256 * i + 4 * lane; const f32x4 w = *(const f32x4*)(nw + d0);
        u32x2 o; o.x = pk2(x[i][0] * rstd * w[0], x[i][1] * rstd * w[1]); o.y = pk2(x[i][2] * rstd * w[2], x[i][3] * rstd * w[3]); *(u32x2*)(dst + d0) = o; }
}
DI void phase_norm(const int tid, CArgs& a, int layer, const float* xp, const float* xs, unsigned char* sm, bool prompt_rows = true) {
    const int wid = tid >> 6, lane = tid & 63;
    const float* nw = a.in[I_NW] + layer * 1024;
    bf16_t* XN = (bf16_t*)(a.ws + W_XN);
    if (prompt_rows) {
        f32x4 xn_[4];
        { const int row = blockIdx.x * 8 + wid; if (row < MP) {
#pragma unroll
            for (int i = 0; i < 4; ++i) xn_[i] = *(const f32x4*)(xp + (size_t)row * 1024 + 256 * i + 4 * lane); } }
        for (int row = blockIdx.x * 8 + wid; row < MP; row += gridDim.x * 8) {
            f32x4 x[4]; float ss = 0.f;
#pragma unroll
            for (int i = 0; i < 4; ++i) { x[i] = xn_[i]; ss += x[i][0] * x[i][0] + x[i][1] * x[i][1] + x[i][2] * x[i][2] + x[i][3] * x[i][3]; }
            { const int nrow = row + gridDim.x * 8; if (nrow < MP) {
#pragma unroll
                for (int i = 0; i < 4; ++i) xn_[i] = *(const f32x4*)(xp + (size_t)nrow * 1024 + 256 * i + 4 * lane); } }
            ss = wave_sum(ss);
            const float rstd = rsqrtf(ss * (1.0f / 1024.0f) + EPS);
#pragma unroll
            for (int i = 0; i < 4; ++i) { const int d0 = 256 * i + 4 * lane; const f32x4 w = *(const f32x4*)(nw + d0);
                u32x2 o; o.x = pk2(x[i][0] * rstd * w[0], x[i][1] * rstd * w[1]); o.y = pk2(x[i][2] * rstd * w[2], x[i][3] * rstd * w[3]); *(u32x2*)(XN + (size_t)row * 1024 + d0) = o; }
        }
    }
    norm_sample_rows(tid, a, layer, xs);
}
DI void phase_final_norm(const int tid, CArgs& a) {
    const int wid = tid >> 6, lane = tid & 63; const float* nw = a.in[I_FNW];
    f32x4 xn_[4];
    { const int row = blockIdx.x * 8 + wid; if (row < MT) {
#pragma unroll
        for (int i = 0; i < 4; ++i) xn_[i] = *(const f32x4*)(a.out + (size_t)row * 1024 + 256 * i + 4 * lane); } }
    for (int row = blockIdx.x * 8 + wid; row < MT; row += gridDim.x * 8) {
        float* p = a.out + (size_t)row * 1024; f32x4 x[4]; float ss = 0.f;
#pragma unroll
        for (int i = 0; i < 4; ++i) { x[i] = xn_[i]; ss += x[i][0] * x[i][0] + x[i][1] * x[i][1] + x[i][2] * x[i][2] + x[i][3] * x[i][3]; }
        { const int nrow = row + gridDim.x * 8; if (nrow < MT) {
#pragma unroll
            for (int i = 0; i < 4; ++i) xn_[i] = *(const f32x4*)(a.out + (size_t)nrow * 1024 + 256 * i + 4 * lane); } }
        ss = wave_sum(ss); const float rstd = rsqrtf(ss * (1.0f / 1024.0f) + EPS);
#pragma unroll
        for (int i = 0; i < 4; ++i) { const f32x4 w = *(const f32x4*)(nw + 256 * i + 4 * lane); *(f32x4*)(p + 256 * i + 4 * lane) = x[i] * rstd * w; }
    }
}

template <bool ML>
DI void seq_mixer(const int tid, CArgs& a, int layer, int b, int h, unsigned char* sm) {
    const int wid = tid >> 6, lane = tid & 63, r = lane & 31, hh = lane >> 5;
    bf16_t* Qs = (bf16_t*)(sm); bf16_t* Ks = (bf16_t*)(sm + 18432); bf16_t* Vt = (bf16_t*)(sm + 36864); bf16_t* Kwt = (bf16_t*)(sm + 54272);
    bf16_t* Ps = (bf16_t*)(sm + 71680); bf16_t* Tt = (bf16_t*)(sm + 106496);
    float* vecs = (float*)(sm + 124928);
    float* den = vecs + 1280; float* dst = den + 128; float* nvec = dst + 128; float* stat = nvec + 128;
    const bf16_t* proj = (const bf16_t*)(a.ws + W_PROJ); bf16_t* MIX = (bf16_t*)(a.ws + W_MIX);
    const float* rope = (const float*)(a.ws + W_ROPE);
    const int QOFF = (ML ? 1024 : 0) + h * 64, KOFF = QOFF + 256, VOFF = QOFF + 512, OOFF = 1792 + h * 64, GOFF = (ML ? 2048 : 768) + h * 64, MIXOFF = (ML ? 256 : 0) + h * 64;
    const float* gn = a.in[ML ? I_MGN : I_RGN] + layer * 256 + h * 64;
    const float lg2 = log2f(1.0f - exp2f(-5.0f - (float)h));
    const int lt = wid >> 1, et = wid & 1, l = 32 * lt + r;
    for (int i = tid; i < 64 * 72; i += 512) Tt[i] = 0;
    if (tid < 64) nvec[tid] = 0.f;
    if (!ML && tid < 128) { vecs[tid] = exp2f(lg2 * (float)(tid + 1)); vecs[512 + tid] = exp2f(lg2 * (float)(127 - tid)); }
    f32x16 accT;
#pragma unroll
    for (int i = 0; i < 16; ++i) accT[i] = 0.f;
    float mprev = 0.f; const float bi_ = ML ? a.in[I_BI][layer * 4 + h] : 0.f, bf_ = ML ? a.in[I_BF][layer * 4 + h] : 0.f;
    int cur = 0;
    const int pl = tid & 127, pd8 = tid >> 7, ql = tid >> 2, qc = tid & 3;
    f32x4 gnl[4];
#pragma unroll
    for (int q = 0; q < 4; ++q) gnl[q] = *(const f32x4*)(gn + 32 * et + 8 * q + 4 * hh);
    u32x4 nq1, nq2, nk1, nk2, nv1, nv2; f32x4 ncs[4]; float ng0 = 0.f, ng1 = 0.f, ng2 = 0.f, ng3 = 0.f;
    auto issue_chunk = [&](int cc) {
        const bf16_t* base = proj + (size_t)(b * 2048 + cc * 128 + pl) * NPROJ; const bf16_t* baseq = proj + (size_t)(b * 2048 + cc * 128 + ql) * NPROJ;
        nq1 = *(const u32x4*)(baseq + QOFF + 8 * qc); nq2 = *(const u32x4*)(baseq + QOFF + 32 + 8 * qc);
        nk1 = *(const u32x4*)(baseq + KOFF + 8 * qc); nk2 = *(const u32x4*)(baseq + KOFF + 32 + 8 * qc);
        nv1 = *(const u32x4*)(base + VOFF + 8 * pd8); nv2 = *(const u32x4*)(base + VOFF + 32 + 8 * pd8);
        if (!ML) { const float* cs = rope + ((size_t)(cc * 128 + ql) * 32 + 8 * qc) * 2;
#pragma unroll
            for (int q = 0; q < 4; ++q) ncs[q] = *(const f32x4*)(cs + 4 * q); }
        if (ML && wid == 5) { const bf16_t* gp = proj + (size_t)(b * 2048 + cc * 128 + 2 * lane) * NPROJ + 3328; ng0 = bf2f(gp[h]); ng1 = bf2f(gp[4 + h]); ng2 = bf2f(gp[NPROJ + h]); ng3 = bf2f(gp[NPROJ + 4 + h]); }
    };
    auto gate_scan = [&](int cc) {
        float* V = vecs + (cc & 1) * 640; const int l0 = 2 * lane;
        const float gi0 = ng0 + bi_, gf0 = ng1 + bf_, gi1 = ng2 + bi_, gf1 = ng3 + bf_;
        const float lf0 = logsigf_(gf0), lf1 = logsigf_(gf1);
        float sc = lf0 + lf1;
#pragma unroll
        for (int o = 1; o < 64; o <<= 1) { const float t = __shfl_up(sc, o); if (lane >= o) sc += t; }
        const float b0 = sc - lf1, b1 = sc, g0 = gi0 - b0, g1 = gi1 - b1;
        float mx = fmaxf(g0, g1);
#pragma unroll
        for (int o = 1; o < 64; o <<= 1) { const float t = __shfl_up(mx, o); if (lane >= o) mx = fmaxf(mx, t); }
        float pv = __shfl_up(mx, 1); if (lane == 0) pv = -3.0e38f;
        const float M0 = fmaxf(mprev, fmaxf(pv, g0)), M1 = fmaxf(mprev, mx);
        V[l0] = __expf(mprev - M0); V[l0 + 1] = __expf(mprev - M1);
        V[128 + l0] = __expf(-(b0 + M0)); V[128 + l0 + 1] = __expf(-(b1 + M1));
        V[256 + l0] = g0; V[256 + l0 + 1] = g1; V[384 + l0] = M0; V[384 + l0 + 1] = M1;
        const float M127 = __shfl(M1, 63), b127 = __shfl(b1, 63);
        V[512 + l0] = __expf(g0 - M127); V[512 + l0 + 1] = __expf(g1 - M127);
        mprev = b127 + M127;
    };
    issue_chunk(0);
    if (ML && wid == 5) gate_scan(0);
    for (int c = 0; c < 16; ++c) {
        const int tok0 = b * 2048 + c * 128;
        float* V = vecs + (ML ? (c & 1) * 640 : 0);
        float* wst = V; float* emt = V + 128; float* gvec = V + 256; float* Mvec = V + 384; float* wl = V + 512;
        u32x2 owr[4], gwr[4];
        { const bf16_t* rowp = proj + (size_t)(tok0 + 32 * lt + (lane >> 3)) * NPROJ + 32 * et + 4 * (lane & 7);
#pragma unroll
          for (int i = 0; i < 4; ++i) { owr[i] = ML ? *(const u32x2*)(rowp + (size_t)(8 * i) * NPROJ + OOFF) : (u32x2){0u, 0u}; gwr[i] = *(const u32x2*)(rowp + (size_t)(8 * i) * NPROJ + GOFF); } }
        bf16_t* stgC = Ks + wid * 1152;
        bf16_t* stgD = Ps + wid * 1152;
        if (ML && tid < 128) den[tid] = 0.f;
        {
            const int d8 = pd8;
            const u32x4 q1 = nq1, q2 = nq2, k1 = nk1, k2 = nk2, v1 = nv1, v2 = nv2;
            float qa[8], qb[8], ka[8], kb[8]; unpack8(q1, qa); unpack8(q2, qb); unpack8(k1, ka); unpack8(k2, kb);
            if (!ML) {
#pragma unroll
                for (int j = 0; j < 8; ++j) { const float co = ncs[j >> 1][(j & 1) * 2], si = ncs[j >> 1][(j & 1) * 2 + 1];
                    const float x1 = qa[j], x2 = qb[j]; qa[j] = x1 * co - x2 * si; qb[j] = x1 * si + x2 * co;
                    const float y1 = ka[j], y2 = kb[j]; ka[j] = y1 * co - y2 * si; kb[j] = y1 * si + y2 * co; }
            }
#pragma unroll
            for (int j = 0; j < 8; ++j) { ka[j] *= 0.125f; kb[j] *= 0.125f; }
            *(u32x4*)(Qs + ql * 72 + 8 * qc) = pack8(qa); *(u32x4*)(Qs + ql * 72 + 32 + 8 * qc) = pack8(qb);
            *(u32x4*)(Ks + ql * 72 + 8 * qc) = pack8(ka); *(u32x4*)(Ks + ql * 72 + 32 + 8 * qc) = pack8(kb);
            const unsigned vv1[4] = {v1.x, v1.y, v1.z, v1.w}, vv2[4] = {v2.x, v2.y, v2.z, v2.w};
#pragma unroll
            for (int j = 0; j < 4; ++j) {
                Vt[(8 * d8 + 2 * j) * 136 + pl] = (bf16_t)(vv1[j] & 0xffffu); Vt[(8 * d8 + 2 * j + 1) * 136 + pl] = (bf16_t)(vv1[j] >> 16);
                Vt[(32 + 8 * d8 + 2 * j) * 136 + pl] = (bf16_t)(vv2[j] & 0xffffu); Vt[(32 + 8 * d8 + 2 * j + 1) * 136 + pl] = (bf16_t)(vv2[j] >> 16); }
            if (c < 15) issue_chunk(c + 1);
        }
        __syncthreads();
        const float wsl = ML ? wst[127] : exp2f(lg2 * 128.0f);
        {
            const float Ml = ML ? Mvec[l] : 0.f; float dsum = 0.f;
#pragma unroll
            for (int mi = 0; mi < 2; ++mi) {
                const int mt = 2 * (wid & 1) + mi;
                if (mt <= lt) {
                    f32x16 acc;
#pragma unroll
                    for (int i = 0; i < 16; ++i) acc[i] = 0.f;
#pragma unroll
                    for (int ks = 0; ks < 4; ++ks) { const bf16x8 af = *(const bf16x8*)(Ks + (32 * mt + r) * 72 + 16 * ks + 8 * hh), bq = *(const bf16x8*)(Qs + l * 72 + 16 * ks + 8 * hh); acc = mfma32(af, bq, acc); }
#pragma unroll
                    for (int q = 0; q < 4; ++q) { float pv[4];
#pragma unroll
                        for (int j = 0; j < 4; ++j) { const int m = 32 * mt + 8 * q + 4 * hh + j;
                            float w;
                            if (ML) w = __expf(fminf(gvec[m] - Ml, 0.f)); else w = exp2f(lg2 * (float)max(l - m, 0));
                            w = (m <= l) ? w : 0.f;
                            pv[j] = acc[4 * q + j] * w; dsum += pv[j]; }
                        u32x2 o; o.x = pk2(pv[0], pv[1]); o.y = pk2(pv[2], pv[3]); *(u32x2*)(Ps + l * 136 + 32 * mt + 8 * q + 4 * hh) = o; }
                }
            }
            if (ML) { dsum += __shfl_xor(dsum, 32); if (hh == 0) atomicAdd(&den[l], dsum); }
            { const int m = tid & 127, dq = tid >> 7; const float w = wl[m];
              const u32x4 k1 = *(const u32x4*)(Ks + m * 72 + 16 * dq), k2 = *(const u32x4*)(Ks + m * 72 + 16 * dq + 8);
              float ka[8], kb[8]; unpack8(k1, ka); unpack8(k2, kb);
#pragma unroll
              for (int j = 0; j < 8; ++j) { Kwt[(16 * dq + j) * 136 + m] = f2bf(ka[j] * w); Kwt[(16 * dq + 8 + j) * 136 + m] = f2bf(kb[j] * w); } }
            if (ML && tid < 128) { float sacc = 0.f; const float* nv = nvec + cur * 64;
#pragma unroll
                for (int d8 = 0; d8 < 8; ++d8) { float qv[8]; unpack8(*(const u32x4*)(Qs + tid * 72 + 8 * d8), qv);
#pragma unroll
                    for (int j = 0; j < 8; ++j) sacc += qv[j] * nv[8 * d8 + j]; }
                dst[tid] = sacc; }
        }
        __syncthreads();
        f32x16 acc;
        {
#pragma unroll
            for (int i = 0; i < 16; ++i) acc[i] = 0.f;
            const bf16_t* Tc = Tt + cur * 64 * 72;
#pragma unroll
            for (int ks = 0; ks < 4; ++ks) { const bf16x8 af = *(const bf16x8*)(Tc + (32 * et + r) * 72 + 16 * ks + 8 * hh), bq = *(const bf16x8*)(Qs + l * 72 + 16 * ks + 8 * hh); acc = mfma32(af, bq, acc); }
            const float ws_ = wst[l];
#pragma unroll
            for (int i = 0; i < 16; ++i) acc[i] *= ws_;
            for (int ks = 0; ks < 2 * (lt + 1); ++ks) { const bf16x8 af = *(const bf16x8*)(Vt + (32 * et + r) * 136 + 16 * ks + 8 * hh), bp = *(const bf16x8*)(Ps + l * 136 + 16 * ks + 8 * hh); acc = mfma32(af, bp, acc); }
            if (ML) {
                const float dn = den[l] + ws_ * dst[l]; const float sc = 1.0f / fmaxf(fabsf(dn), emt[l]);
#pragma unroll
                for (int i = 0; i < 4; ++i) *(u32x2*)(stgC + ((lane >> 3) + 8 * i) * 36 + 4 * (lane & 7)) = owr[i];
                wave_lds_fence();
#pragma unroll
                for (int q = 0; q < 4; ++q) { const u32x2 ow = *(const u32x2*)(stgC + r * 36 + 8 * q + 4 * hh);
                    acc[4 * q + 0] *= sc * sigmoidf_(bflo(ow.x)); acc[4 * q + 1] *= sc * sigmoidf_(bfhi(ow.x));
                    acc[4 * q + 2] *= sc * sigmoidf_(bflo(ow.y)); acc[4 * q + 3] *= sc * sigmoidf_(bfhi(ow.y)); }
            }
            float s1 = 0.f, s2 = 0.f;
#pragma unroll
            for (int i = 0; i < 16; ++i) { s1 += acc[i]; s2 += acc[i] * acc[i]; }
            s1 += __shfl_xor(s1, 32); s2 += __shfl_xor(s2, 32);
            if (hh == 0) *(f32x2*)(stat + (et * 128 + l) * 2) = (f32x2){s1, s2};
        }
        if (wid < 4) {
            const int et2 = wid >> 1, dt2 = wid & 1;
#pragma unroll
            for (int i = 0; i < 16; ++i) accT[i] *= wsl;
#pragma unroll
            for (int ks = 0; ks < 8; ++ks) { const bf16x8 af = *(const bf16x8*)(Vt + (32 * et2 + r) * 136 + 16 * ks + 8 * hh), bk = *(const bf16x8*)(Kwt + (32 * dt2 + r) * 136 + 16 * ks + 8 * hh); accT = mfma32(af, bk, accT); }
            bf16_t* Tn = Tt + (cur ^ 1) * 64 * 72;
#pragma unroll
            for (int i = 0; i < 16; ++i) Tn[(32 * et2 + (i & 3) + 8 * (i >> 2) + 4 * hh) * 72 + 32 * dt2 + r] = f2bf(accT[i]);
        } else if (ML && wid == 4) {
            float sacc = 0.f;
#pragma unroll
            for (int m8 = 0; m8 < 16; ++m8) { float kv[8]; unpack8(*(const u32x4*)(Kwt + lane * 136 + 8 * m8), kv);
#pragma unroll
                for (int j = 0; j < 8; ++j) sacc += kv[j]; }
            nvec[(cur ^ 1) * 64 + lane] = wsl * nvec[cur * 64 + lane] + sacc;
        } else if (ML && wid == 5 && c < 15) gate_scan(c + 1);
        __syncthreads();
        {
            const f32x2 sa = *(const f32x2*)(stat + l * 2), sb = *(const f32x2*)(stat + (128 + l) * 2);
            const float mu = (sa[0] + sb[0]) * (1.0f / 64.0f), var = fmaxf((sa[1] + sb[1]) * (1.0f / 64.0f) - mu * mu, 0.f), rs = rsqrtf(var + EPS);
#pragma unroll
            for (int i = 0; i < 4; ++i) *(u32x2*)(stgD + ((lane >> 3) + 8 * i) * 36 + 4 * (lane & 7)) = gwr[i];
            wave_lds_fence();
            u32x2 wv[4];
#pragma unroll
            for (int q = 0; q < 4; ++q) { const u32x2 g2 = *(const u32x2*)(stgD + r * 36 + 8 * q + 4 * hh);
                wv[q].x = pk2((acc[4 * q] - mu) * rs * gnl[q][0] * siluf_(bflo(g2.x)), (acc[4 * q + 1] - mu) * rs * gnl[q][1] * siluf_(bfhi(g2.x)));
                wv[q].y = pk2((acc[4 * q + 2] - mu) * rs * gnl[q][2] * siluf_(bflo(g2.y)), (acc[4 * q + 3] - mu) * rs * gnl[q][3] * siluf_(bfhi(g2.y))); }
            wave_lds_fence();
#pragma unroll
            for (int q = 0; q < 4; ++q) *(u32x2*)(stgD + r * 36 + 8 * q + 4 * hh) = wv[q];
            wave_lds_fence();
            bf16_t* mp = MIX + (size_t)(tok0 + 32 * lt + (lane >> 3)) * 1024 + MIXOFF + 32 * et + 4 * (lane & 7);
#pragma unroll
            for (int i = 0; i < 4; ++i) *(u32x2*)(mp + (size_t)(8 * i) * 1024) = *(const u32x2*)(stgD + ((lane >> 3) + 8 * i) * 36 + 4 * (lane & 7));
        }
        cur ^= 1;
    }
    __syncthreads();
    const size_t sidx = (size_t)((layer * 8 + b) * 4 + h);
    if (wid < 4) { const int et2 = wid >> 1, dt2 = wid & 1; float* so = a.out + (ML ? O_MLCP : O_RETP) + sidx * 4096;
#pragma unroll
        for (int i = 0; i < 16; ++i) { const int e = 32 * et2 + (i & 3) + 8 * (i >> 2) + 4 * hh, d = 32 * dt2 + r; if (ML) so[e * 64 + d] = accT[i]; else so[d * 64 + e] = accT[i]; } }
    if (ML) { if (wid == 4) a.out[O_MLNP + sidx * 64 + lane] = nvec[cur * 64 + lane]; if (wid == 5 && lane == 0) a.out[O_MLMP + sidx] = mprev; }
}

DI void s5_prompt(const int tid, CArgs& a, int layer, int b, int g, unsigned char* sm) {
    const int wid = tid >> 6, lane = tid & 63, fr = lane & 15, fq = lane >> 4;
    float* buf = (float*)sm + wid * 16 * 132; float* Ew = (float*)(sm + 8 * 16 * 132 * 4);
    const bf16_t* proj = (const bf16_t*)(a.ws + W_PROJ); bf16_t* SY = (bf16_t*)(a.ws + W_SY);
    const int lgi = layer * 16 + g;
    const f32x2 ab = ((const f32x2*)(a.ws + W_ABAR))[lgi * 64 + lane];
    const bf16_t* bbm = (const bf16_t*)(a.ws + W_BBM) + (size_t)lgi * 128 * 16; const bf16_t* cm = (const bf16_t*)(a.ws + W_CM) + (size_t)lgi * 16 * 128;
    const bf16x8 zero8 = {0, 0, 0, 0, 0, 0, 0, 0};
    bf16x8 bbf[8], cf[4];
#pragma unroll
    for (int nt = 0; nt < 8; ++nt) bbf[nt] = lane < 32 ? *(const bf16x8*)(bbm + (16 * nt + fr) * 16 + 8 * fq) : zero8;
#pragma unroll
    for (int ks = 0; ks < 4; ++ks) cf[ks] = *(const bf16x8*)(cm + fr * 128 + 32 * ks + 8 * fq);
    const float dsk = a.in[I_S5D][layer * 256 + g * 16 + fr];
    const int tok0 = b * 2048 + 256 * wid;
    float xr = 0.f, xi = 0.f;
    const bf16_t* ubase = proj + (size_t)tok0 * NPROJ + 2304 + g * 16;
    for (int pass = 0; pass < 2; ++pass) {
        bf16x8 uf_n = lane < 32 ? *(const bf16x8*)(ubase + (size_t)fr * NPROJ + 8 * (fq & 1)) : zero8;
        bf16_t u4_n[4];
#pragma unroll
        for (int i = 0; i < 4; ++i) u4_n[i] = pass == 1 ? ubase[(size_t)(4 * fq + i) * NPROJ + fr] : (bf16_t)0;
        for (int it = 0; it < 16; ++it) {
            const bf16x8 uf = uf_n; bf16_t u4[4];
#pragma unroll
            for (int i = 0; i < 4; ++i) u4[i] = u4_n[i];
            if (it < 15) {
                uf_n = lane < 32 ? *(const bf16x8*)(ubase + (size_t)(16 * (it + 1) + fr) * NPROJ + 8 * (fq & 1)) : zero8;
                if (pass == 1) {
#pragma unroll
                    for (int i = 0; i < 4; ++i) u4_n[i] = ubase[(size_t)(16 * (it + 1) + 4 * fq + i) * NPROJ + fr]; }
            }
#pragma unroll
            for (int nt = 0; nt < 8; ++nt) { f32x4 z = {0.f, 0.f, 0.f, 0.f}; z = mfma16(uf, bbf[nt], z);
#pragma unroll
                for (int i = 0; i < 4; ++i) buf[(4 * fq + i) * 132 + 16 * nt + fr] = z[i]; }
            wave_lds_fence();
#pragma unroll
            for (int t = 0; t < 16; ++t) { const float br = buf[t * 132 + lane], bi = buf[t * 132 + 64 + lane];
                const float nr = ab.x * xr - ab.y * xi + br, ni = ab.x * xi + ab.y * xr + bi; xr = nr; xi = ni;
                if (pass == 1) { buf[t * 132 + lane] = xr; buf[t * 132 + 64 + lane] = xi; } }
            if (pass == 1) {
                wave_lds_fence();
                f32x4 y = {0.f, 0.f, 0.f, 0.f};
#pragma unroll
                for (int ks = 0; ks < 4; ++ks) { const f32x4 x0 = *(const f32x4*)(buf + fr * 132 + 32 * ks + 8 * fq), x1 = *(const f32x4*)(buf + fr * 132 + 32 * ks + 8 * fq + 4);
                    u32x4 w; w.x = pk2(x0[0], x0[1]); w.y = pk2(x0[2], x0[3]); w.z = pk2(x1[0], x1[1]); w.w = pk2(x1[2], x1[3]);
                    y = mfma16(__builtin_bit_cast(bf16x8, w), cf[ks], y); }
#pragma unroll
                for (int i = 0; i < 4; ++i) { const size_t trow = (size_t)(tok0 + 16 * it + 4 * fq + i);
                    SY[trow * 256 + g * 16 + fr] = f2bf(gelu_tanh(y[i] + dsk * bf2f(u4[i]))); }
            }
            wave_lds_fence();
        }
        if (pass == 0) {
            Ew[wid * 128 + lane] = xr; Ew[wid * 128 + 64 + lane] = xi;
            __syncthreads();
            float pr = ab.x, pi = ab.y;
#pragma unroll
            for (int s = 0; s < 8; ++s) { const float nr = pr * pr - pi * pi, ni = 2.f * pr * pi; pr = nr; pi = ni; }
            xr = 0.f; xi = 0.f;
            for (int j = 0; j < wid; ++j) { const float er = Ew[j * 128 + lane], ei = Ew[j * 128 + 64 + lane]; const float nr = pr * xr - pi * xi + er, ni = pr * xi + pi * xr + ei; xr = nr; xi = ni; }
        }
    }
    if (wid == 7) { const size_t o = (size_t)((layer * 8 + b) * 16 + g) * 64 + lane; a.out[O_S5RP + o] = xr; a.out[O_S5IP + o] = xi; }
}

DI void xattn_prompt(const int tid, CArgs& a, int layer, int b, int h, int qt, unsigned char* sm) {
    const int wid = tid >> 6, lane = tid & 63, r = lane & 31, hh = lane >> 5;
    bf16_t* Kx = (bf16_t*)sm; bf16_t* Vxt = (bf16_t*)(sm + 36864);
    const float* mk = a.out + O_MEMK + (size_t)(layer * 8 + b) * 65536 + h * 64; const float* mv = a.out + O_MEMV + (size_t)(layer * 8 + b) * 65536 + h * 64;
    const bf16_t* proj = (const bf16_t*)(a.ws + W_PROJ); bf16_t* MIX = (bf16_t*)(a.ws + W_MIX);
#pragma unroll
    for (int i = 0; i < 8; ++i) { const int idx = i * 512 + tid; { const int m = idx >> 4, d4 = idx & 15; const f32x4 v = *(const f32x4*)(mk + (size_t)m * 256 + 4 * d4); u32x2 w; w.x = pk2(v[0], v[1]); w.y = pk2(v[2], v[3]); *(u32x2*)(Kx + m * 72 + 4 * d4) = w; }
        { const int m = idx & 255, d4 = idx >> 8; const f32x4 v = *(const f32x4*)(mv + (size_t)m * 256 + 4 * d4);
#pragma unroll
          for (int j = 0; j < 4; ++j) Vxt[(4 * d4 + j) * 264 + m] = f2bf(v[j]); } }
    __syncthreads();
    const size_t trow = (size_t)b * 2048 + qt * 256 + 32 * wid + r;
    bf16x8 qf[4];
#pragma unroll
    for (int ks = 0; ks < 4; ++ks) qf[ks] = *(const bf16x8*)(proj + trow * NPROJ + 2816 + h * 64 + 16 * ks + 8 * hh);
    f32x16 acc[8];
#pragma unroll
    for (int mt = 0; mt < 8; ++mt) {
#pragma unroll
        for (int i = 0; i < 16; ++i) acc[mt][i] = 0.f;
#pragma unroll
        for (int ks = 0; ks < 4; ++ks) { const bf16x8 af = *(const bf16x8*)(Kx + (32 * mt + r) * 72 + 16 * ks + 8 * hh); acc[mt] = mfma32(af, qf[ks], acc[mt]); }
    }
    float mx = -3.0e38f;
#pragma unroll
    for (int mt = 0; mt < 8; ++mt)
#pragma unroll
        for (int i = 0; i < 16; ++i) mx = fmaxf(mx, acc[mt][i]);
    mx = fmaxf(mx, __shfl_xor(mx, 32));
    float sum = 0.f;
#pragma unroll
    for (int mt = 0; mt < 8; ++mt)
#pragma unroll
        for (int i = 0; i < 16; ++i) { const float p = exp2f((acc[mt][i] - mx) * (0.125f * 1.4426950408889634f)); acc[mt][i] = p; sum += p; }
    sum += __shfl_xor(sum, 32);
    f32x16 o[2];
#pragma unroll
    for (int et = 0; et < 2; ++et)
#pragma unroll
        for (int i = 0; i < 16; ++i) o[et][i] = 0.f;
#pragma unroll
    for (int mt = 0; mt < 8; ++mt)
#pragma unroll
        for (int s = 0; s < 2; ++s) {
            u32x4 pw; pw.x = pk2(acc[mt][8 * s], acc[mt][8 * s + 1]); pw.y = pk2(acc[mt][8 * s + 2], acc[mt][8 * s + 3]); pw.z = pk2(acc[mt][8 * s + 4], acc[mt][8 * s + 5]); pw.w = pk2(acc[mt][8 * s + 6], acc[mt][8 * s + 7]);
            const bf16x8 pb = __builtin_bit_cast(bf16x8, pw);
#pragma unroll
            for (int et = 0; et < 2; ++et) { const bf16_t* vp = Vxt + (32 * et + r) * 264 + 32 * mt + 16 * s + 4 * hh;
                const u32x2 lo = *(const u32x2*)vp, hi = *(const u32x2*)(vp + 8); u32x4 aw; aw.x = lo.x; aw.y = lo.y; aw.z = hi.x; aw.w = hi.y;
                o[et] = mfma32(__builtin_bit_cast(bf16x8, aw), pb, o[et]); }
        }
    const float inv = 1.0f / sum;
#pragma unroll
    for (int et = 0; et < 2; ++et)
#pragma unroll
        for (int q = 0; q < 4; ++q) { const int e0 = 32 * et + 8 * q + 4 * hh; const u32x2 gw = *(const u32x2*)(proj + trow * NPROJ + 3072 + h * 64 + e0);
            u32x2 w; w.x = pk2(o[et][4 * q] * inv * siluf_(bflo(gw.x)), o[et][4 * q + 1] * inv * siluf_(bfhi(gw.x))); w.y = pk2(o[et][4 * q + 2] * inv * siluf_(bflo(gw.y)), o[et][4 * q + 3] * inv * siluf_(bfhi(gw.y)));
            *(u32x2*)(MIX + trow * 1024 + 768 + h * 64 + e0) = w; }
}

DI void ret_sample(const int tid, CArgs& a, int layer, int id) {
    const int lane = tid & 63, b = id >> 2, h = id & 3;
    const bf16_t* prow = (const bf16_t*)(a.ws + W_PROJ) + (size_t)(MP + b) * NPROJ; const float* rope = (const float*)(a.ws + W_ROPE) + (size_t)2048 * 64;
    const float co = rope[2 * (lane & 31)], si = rope[2 * (lane & 31) + 1];
    float q = bf2f(prow[h * 64 + lane]), k = bf2f(prow[256 + h * 64 + lane]); const float v = bf2f(prow[512 + h * 64 + lane]);
    { const float qp = __shfl_xor(q, 32), kp = __shfl_xor(k, 32); q = lane < 32 ? q * co - qp * si : qp * si + q * co; k = (lane < 32 ? k * co - kp * si : kp * si + k * co) * 0.125f; }
    const float qk = wave_sum(q * k), gam = 1.0f - exp2f(-5.0f - (float)h);
    const size_t sidx = (size_t)((layer * 128 + b) * 4 + h) * 4096;
    const float* S0 = a.in[I_SRET] + sidx; float* So = a.out + O_RETS + sidx;
    const int sub = lane >> 4, e4 = lane & 15;
    f32x4 v4; v4[0] = __shfl(v, 4 * e4); v4[1] = __shfl(v, 4 * e4 + 1); v4[2] = __shfl(v, 4 * e4 + 2); v4[3] = __shfl(v, 4 * e4 + 3);
    f32x4 acc = {0.f, 0.f, 0.f, 0.f};
#pragma unroll 4
    for (int it = 0; it < 16; ++it) { const int d = 4 * it + sub; const f32x4 s4 = *(const f32x4*)(S0 + d * 64 + 4 * e4); const float qd = __shfl(q, d), kd = __shfl(k, d);
        acc += qd * s4; *(f32x4*)(So + d * 64 + 4 * e4) = gam * s4 + kd * v4; }
#pragma unroll
    for (int j = 0; j < 4; ++j) { acc[j] += __shfl_xor(acc[j], 16); acc[j] += __shfl_xor(acc[j], 32); }
    f32x4 o = qk * v4 + gam * acc;
    float s = o[0] + o[1] + o[2] + o[3]; s += __shfl_xor(s, 1); s += __shfl_xor(s, 2); s += __shfl_xor(s, 4); s += __shfl_xor(s, 8); const float mu = s * (1.0f / 64.0f);
    o -= mu; float q2 = o[0] * o[0] + o[1] * o[1] + o[2] * o[2] + o[3] * o[3]; q2 += __shfl_xor(q2, 1); q2 += __shfl_xor(q2, 2); q2 += __shfl_xor(q2, 4); q2 += __shfl_xor(q2, 8);
    const float rs = rsqrtf(q2 * (1.0f / 64.0f) + EPS);
    if (sub == 0) { const float* gn = a.in[I_RGN] + layer * 256 + h * 64 + 4 * e4; const u32x2 gw = *(const u32x2*)(prow + 768 + h * 64 + 4 * e4);
        u32x2 w; w.x = pk2(o[0] * rs * gn[0] * siluf_(bflo(gw.x)), o[1] * rs * gn[1] * siluf_(bfhi(gw.x))); w.y = pk2(o[2] * rs * gn[2] * siluf_(bflo(gw.y)), o[3] * rs * gn[3] * siluf_(bfhi(gw.y)));
        *(u32x2*)((bf16_t*)(a.ws + W_MIX) + (size_t)(MP + b) * 1024 + h * 64 + 4 * e4) = w; }
}
DI void mlstm_sample(const int tid, CArgs& a, int layer, int id) {
    const int lane = tid & 63, b = id >> 2, h = id & 3;
    const bf16_t* prow = (const bf16_t*)(a.ws + W_PROJ) + (size_t)(MP + b) * NPROJ; const float gp[8] = {bf2f(prow[3328]), bf2f(prow[3329]), bf2f(prow[3330]), bf2f(prow[3331]), bf2f(prow[3332]), bf2f(prow[3333]), bf2f(prow[3334]), bf2f(prow[3335])};
    const float q = bf2f(prow[1024 + h * 64 + lane]), k = bf2f(prow[1280 + h * 64 + lane]) * 0.125f, v = bf2f(prow[1536 + h * 64 + lane]), mo = bf2f(prow[1792 + h * 64 + lane]), mg = bf2f(prow[2048 + h * 64 + lane]);
    const float gi = gp[h] + a.in[I_BI][layer * 4 + h], lf = logsigf_(gp[4 + h] + a.in[I_BF][layer * 4 + h]);
    const size_t hidx = (size_t)((layer * 128 + b) * 4 + h);
    const float m0 = a.in[I_SM][hidx], aa = lf + m0, mt = fmaxf(aa, gi), wi = __expf(gi - mt), wsx = __expf(aa - mt);
    const float s = wave_sum(q * k) * wi; const float n0 = a.in[I_SN][hidx * 64 + lane]; const float den = s + wsx * wave_sum(n0 * q);
    const float sc = 1.0f / fmaxf(fabsf(den), __expf(-mt));
    const float* C0 = a.in[I_SC] + hidx * 4096; float* Co = a.out + O_MLCS + hidx * 4096;
    const int sub = lane >> 4, d4 = lane & 15;
    f32x4 q4, k4;
#pragma unroll
    for (int j = 0; j < 4; ++j) { q4[j] = __shfl(q, 4 * d4 + j); k4[j] = __shfl(k, 4 * d4 + j); }
    float hv[16]; float hs = 0.f;
#pragma unroll
    for (int it = 0; it < 16; ++it) { const int e = 4 * it + sub; const f32x4 c4 = *(const f32x4*)(C0 + e * 64 + 4 * d4);
        float dot = c4[0] * q4[0] + c4[1] * q4[1] + c4[2] * q4[2] + c4[3] * q4[3]; dot += __shfl_xor(dot, 1); dot += __shfl_xor(dot, 2); dot += __shfl_xor(dot, 4); dot += __shfl_xor(dot, 8);
        const float ve = __shfl(v, e), moe = __shfl(mo, e);
        *(f32x4*)(Co + e * 64 + 4 * d4) = wsx * c4 + (wi * ve) * k4;
        hv[it] = (s * ve + wsx * dot) * sc * sigmoidf_(moe); hs += hv[it]; }
    hs += __shfl_xor(hs, 16); hs += __shfl_xor(hs, 32); const float mu = hs * (1.0f / 64.0f);
    float q2 = 0.f;
#pragma unroll
    for (int it = 0; it < 16; ++it) { hv[it] -= mu; q2 += hv[it] * hv[it]; }
    q2 += __shfl_xor(q2, 16); q2 += __shfl_xor(q2, 32); const float rs = rsqrtf(q2 * (1.0f / 64.0f) + EPS);
    const float* gn = a.in[I_MGN] + layer * 256 + h * 64; bf16_t* mp = (bf16_t*)(a.ws + W_MIX) + (size_t)(MP + b) * 1024 + 256 + h * 64;
#pragma unroll
    for (int it = 0; it < 16; ++it) { const int e = 4 * it + sub; const float g = __shfl(mg, e); if (d4 == 0) mp[e] = f2bf(hv[it] * rs * gn[e] * siluf_(g)); }
    a.out[O_MLNS + hidx * 64 + lane] = wsx * n0 + wi * k;
    if (lane == 0) a.out[O_MLMS + hidx] = mt;
}
DI void s5_sample(const int tid, CArgs& a, int layer, int id) {
    const int lane = tid & 63, b = id >> 4, g = id & 15, lgi = layer * 16 + g;
    const bf16_t* prow = (const bf16_t*)(a.ws + W_PROJ) + (size_t)(MP + b) * NPROJ;
    const float uu = bf2f(prow[2304 + g * 16 + (lane & 15)]);
    const size_t sidx = (size_t)((layer * 128 + b) * 16 + g) * 64 + lane;
    const float x0r = a.in[I_S5R][sidx], x0i = a.in[I_S5I][sidx];
    const f32x2 ab = ((const f32x2*)(a.ws + W_ABAR))[lgi * 64 + lane];
    const f32x4* bb = (const f32x4*)((const f32x2*)(a.ws + W_BBF) + (size_t)(lgi * 64 + lane) * 16);
    float bur = 0.f, bui = 0.f;
#pragma unroll
    for (int c2 = 0; c2 < 8; ++c2) { const f32x4 w = bb[c2]; const float u0 = __shfl(uu, 2 * c2), u1 = __shfl(uu, 2 * c2 + 1); bur += w[0] * u0 + w[2] * u1; bui += w[1] * u0 + w[3] * u1; }
    const float xr = ab.x * x0r - ab.y * x0i + bur, xi = ab.x * x0i + ab.y * x0r + bui;
    a.out[O_S5RS + sidx] = xr; a.out[O_S5IS + sidx] = xi;
    float y = 0.f;
#pragma unroll
    for (int ch = 0; ch < 16; ++ch) { const size_t ci = ((size_t)lgi * 16 + ch) * 64 + lane; const float t = wave_sum(a.in[I_CRE][ci] * xr - a.in[I_CIM][ci] * xi); if (lane == ch) y = t; }
    if (lane < 16) { y += a.in[I_S5D][layer * 256 + g * 16 + lane] * uu; ((bf16_t*)(a.ws + W_SY))[(size_t)(MP + b) * 256 + g * 16 + lane] = f2bf(gelu_tanh(y)); }
}
DI void xattn_sample(const int tid, CArgs& a, int layer, int b, unsigned char* sm) {
    const int wid = tid >> 6, lane = tid & 63, hd = lane >> 4, j16 = lane & 15;
    float* sc = (float*)sm; float* po = sc + 1024;
    const bf16_t* prow = (const bf16_t*)(a.ws + W_PROJ) + (size_t)(MP + b) * NPROJ;
    const u32x2 qw = *(const u32x2*)(prow + 2816 + 4 * lane); const f32x4 q4 = {bflo(qw.x), bfhi(qw.x), bflo(qw.y), bfhi(qw.y)};
    const float* Kc = a.in[I_CK] + (size_t)(layer * 128 + b) * 65536 + 4 * lane; const float* Vc = a.in[I_CV] + (size_t)(layer * 128 + b) * 65536 + 4 * lane;
#pragma unroll 16
    for (int i = 0; i < 32; ++i) { const int m = 32 * wid + i; const f32x4 k4 = *(const f32x4*)(Kc + (size_t)m * 256);
        float dot = k4[0] * q4[0] + k4[1] * q4[1] + k4[2] * q4[2] + k4[3] * q4[3]; dot += __shfl_xor(dot, 1); dot += __shfl_xor(dot, 2); dot += __shfl_xor(dot, 4); dot += __shfl_xor(dot, 8);
        if (j16 == 0) sc[hd * 256 + m] = dot * 0.125f; }
    __syncthreads();
    float mx = -3.0e38f;
#pragma unroll
    for (int t = 0; t < 16; ++t) mx = fmaxf(mx, sc[hd * 256 + j16 + 16 * t]);
    mx = fmaxf(mx, __shfl_xor(mx, 1)); mx = fmaxf(mx, __shfl_xor(mx, 2)); mx = fmaxf(mx, __shfl_xor(mx, 4)); mx = fmaxf(mx, __shfl_xor(mx, 8));
    float sum = 0.f;
#pragma unroll
    for (int t = 0; t < 16; ++t) sum += __expf(sc[hd * 256 + j16 + 16 * t] - mx);
    sum += __shfl_xor(sum, 1); sum += __shfl_xor(sum, 2); sum += __shfl_xor(sum, 4); sum += __shfl_xor(sum, 8);
    const float inv = 1.0f / sum;
    f32x4 acc = {0.f, 0.f, 0.f, 0.f};
#pragma unroll 16
    for (int i = 0; i < 32; ++i) { const int m = 32 * wid + i; const f32x4 v4 = *(const f32x4*)(Vc + (size_t)m * 256); const float p = __expf(sc[hd * 256 + m] - mx) * inv; acc += p * v4; }
    *(f32x4*)(po + wid * 256 + 4 * lane) = acc;
    __syncthreads();
    if (tid < 256) { float o = 0.f;
#pragma unroll
        for (int w = 0; w < 8; ++w) o += po[w * 256 + tid];
        ((bf16_t*)(a.ws + W_MIX))[(size_t)(MP + b) * 1024 + 768 + tid] = f2bf(o * siluf_(bf2f(prow[3072 + tid]))); }
}

DI void task_done(const int tid, unsigned* dep) {
    asm volatile("s_waitcnt vmcnt(0)" ::: "memory");
    __syncthreads();
    if (tid == 0) { __threadfence(); __hip_atomic_fetch_add(dep, 1u, __ATOMIC_RELAXED, __HIP_MEMORY_SCOPE_AGENT); }
}
DI void glu_task(const int tid, CArgs& a, int layer, int pm, unsigned* dep0, unsigned char* sm) {
    if (tid == 0) {
        unsigned* dep = dep0 + 16 * (pm < 64 ? (pm >> 3) : 8); const unsigned need = pm < 64 ? 16u : 256u; unsigned sp = 0;
        while (__hip_atomic_load(dep, __ATOMIC_RELAXED, __HIP_MEMORY_SCOPE_AGENT) < need && ++sp < (1u << 22)) __builtin_amdgcn_s_sleep(2);
        __threadfence();
    }
    __syncthreads();
    unsigned char* ws = a.ws;
    pg8::Gemm g; pg8::Epi E; g.ready = nullptr; g.need = 0; g.gate_pm = -1;
    g.A = (const bf16_t*)(ws + W_SY); g.Bt = (const bf16_t*)(ws + W_WGLUT) + (size_t)layer * 65536; g.M = MPAD; g.N = 256; g.K = 256;
    E.mode = 2; E.O = (bf16_t*)(ws + W_MIX); E.SY = (const bf16_t*)(ws + W_SY); E.PROJ = (const bf16_t*)(ws + W_PROJ); E.out = a.out; E.src = a.out; E.xbuf = nullptr; E.pcnt = nullptr; E.nw = nullptr; E.XNo = nullptr;
    pg8::StaticOrder S; S.init_single(pm);
    pg8::gemm_phase(tid, (LAS unsigned char*)sm, g, S, E);
}
DI void phase_mixers(CArgs& a, int layer, unsigned char* sm) {
    unsigned* ctr = (unsigned*)(a.ws + W_CTL) + 16 * layer;
    unsigned* dep0 = (unsigned*)(a.ws + W_CTL) + 256 + 160 * layer;
    volatile int* slot = (volatile int*)(sm + LDS_CTL);
    for (;;) {
        int tid = threadIdx.x; asm volatile("" : "+v"(tid)); const int wid = tid >> 6;
        __syncthreads();
        if (tid == 0) *slot = (int)atomicAdd(ctr, 1u);
        __syncthreads();
        const int t = *slot;
        if (t >= (layer == 0 ? 1449 : 1025)) break;
        if (t < 32) seq_mixer<false>(tid, a, layer, t >> 2, t & 3, sm);
        else if (t < 64) seq_mixer<true>(tid, a, layer, (t - 32) >> 2, (t - 32) & 3, sm);
        else if (t < 192) { s5_prompt(tid, a, layer, (t - 64) >> 4, (t - 64) & 15, sm); task_done(tid, dep0 + 16 * ((t - 64) >> 4)); }
        else if (t < 448) { s5_sample(tid, a, layer, (t - 192) * 8 + wid); task_done(tid, dep0 + 16 * 8); }
        else if (t < 576) xattn_sample(tid, a, layer, t - 448, sm);
        else if (t < 832) { const int u = t - 576; xattn_prompt(tid, a, layer, u >> 5, (u >> 3) & 3, u & 7, sm); }
        else if (t < 897) glu_task(tid, a, layer, t - 832, dep0, sm);
        else if (t < 961) ret_sample(tid, a, layer, (t - 897) * 8 + wid);
        else if (t < 1025) mlstm_sample(tid, a, layer, (t - 961) * 8 + wid);
        else prep_task(tid, a, t - 1025, sm);
    }
}

DI void outproj_sample(const int tid, CArgs& a, int layer, const float* src) {
    const int wid = tid >> 6, lane = tid & 63, fr = lane & 15, fq = lane >> 4;
    const bf16_t* A = (const bf16_t*)(a.ws + W_MIX) + (size_t)MP * 1024; const bf16_t* Bt = (const bf16_t*)(a.ws + W_WOUTT) + (size_t)layer * 1024 * 1024;
    for (int t = blockIdx.x * 8 + wid; t < 512; t += gridDim.x * 8) {
        const int mi = t >> 6, ni = t & 63; f32x4 acc = {0.f, 0.f, 0.f, 0.f};
        const bf16_t* ap = A + (size_t)(16 * mi + fr) * 1024 + 8 * fq; const bf16_t* bp = Bt + (size_t)(16 * ni + fr) * 1024 + 8 * fq;
#pragma unroll 8
        for (int ks = 0; ks < 32; ++ks) acc = mfma16(*(const bf16x8*)(ap + 32 * ks), *(const bf16x8*)(bp + 32 * ks), acc);
#pragma unroll
        for (int i = 0; i < 4; ++i) { const size_t row = (size_t)(16 * mi + 4 * fq + i), col = (size_t)(16 * ni + fr); a.out[O_YS + row * 1024 + col] = src[row * 1024 + col] + acc[i]; }
    }
}

#define XB_TMO      128
#define XB_XCNT(j)  (256  + 64 * (j))
#define XB_XSUB(j)  (1280 + 64 * (j))
#define XB_XGEN(j)  (2304 + 64 * (j))
#define XB_TOP      3328
#define XB_TOPGEN   3392
#define XCD_BAR_WORDS 3456
#define XB_SPIN_CAP (1u << 18)
DI unsigned xb_ld(unsigned* p)              { return __hip_atomic_load(p, __ATOMIC_RELAXED, __HIP_MEMORY_SCOPE_AGENT); }
DI unsigned xb_add(unsigned* p, unsigned v) { return __hip_atomic_fetch_add(p, v, __ATOMIC_RELAXED, __HIP_MEMORY_SCOPE_AGENT); }
DI unsigned xb_xcc_id() { return (unsigned)__builtin_amdgcn_s_getreg((3 << 11) | 20) & 0xFu; }
#define XB_SPIN(cond, bar) do { unsigned _sp = 0; while (cond) { __builtin_amdgcn_s_sleep(1); \
    if ((++_sp & 255u) == 0u) { if (xb_ld(&(bar)[XB_TMO])) break; if (_sp > XB_SPIN_CAP) { atomicAdd(&(bar)[XB_TMO], 1u); break; } } } } while (0)
struct XcdBarrier { unsigned* bar; unsigned x; volatile LAS unsigned* st; };
DI XcdBarrier xcd_barrier_post(unsigned* bar, volatile LAS unsigned* st) {
    XcdBarrier b; b.bar = bar; b.x = xb_xcc_id(); b.st = st;
    if (threadIdx.x == 0) (void)xb_add(&bar[XB_XCNT(b.x)], 1u);
    return b;
}
DI void xcd_barrier_complete(unsigned* bar, unsigned x, unsigned& nloc, unsigned& nx) {
    const unsigned G = gridDim.x * gridDim.y * gridDim.z;
    unsigned sum, cnt, mine, sp = 0u;
    for (;;) {
        sum = 0u; cnt = 0u; mine = 0u;
#pragma unroll
        for (unsigned j = 0; j < 16; ++j) { const unsigned c = xb_ld(&bar[XB_XCNT(j)]); sum += c; cnt += (c > 0u) ? 1u : 0u; mine = (j == x) ? c : mine; }
        if (sum == G) break;
        __builtin_amdgcn_s_sleep(1);
        if ((++sp & 255u) == 0u) { if (xb_ld(&bar[XB_TMO])) break; if (sp > XB_SPIN_CAP) { atomicAdd(&bar[XB_TMO], 1u); break; } }
    }
    nloc = mine > 0u ? mine : 1u; nx = cnt > 0u ? cnt : 1u;
}
DI void xcd_barrier(const XcdBarrier& b) {
    asm volatile("s_waitcnt vmcnt(0)" ::: "memory");
    __syncthreads();
    if (threadIdx.x == 0) {
        unsigned* bar = b.bar;
        __builtin_amdgcn_s_waitcnt(0);
        unsigned nloc = b.st[0], nx = b.st[1];
        if (nloc == 0u) { xcd_barrier_complete(bar, b.x, nloc, nx); b.st[0] = nloc; b.st[1] = nx; }
        const unsigned old = xb_add(&bar[XB_XSUB(b.x)], 1u);
        const unsigned gen = old / nloc;
        if (old + 1u == (gen + 1u) * nloc) {
            __builtin_amdgcn_fence(__ATOMIC_RELEASE, "agent");
            asm volatile("s_waitcnt vmcnt(0)" ::: "memory");
            const unsigned og = xb_add(&bar[XB_TOP], 1u);
            const unsigned tg = og / nx;
            if (og + 1u == (tg + 1u) * nx) xb_add(&bar[XB_TOPGEN], 1u);
            else XB_SPIN(xb_ld(&bar[XB_TOPGEN]) == tg, bar);
            __builtin_amdgcn_fence(__ATOMIC_ACQUIRE, "agent");
            xb_add(&bar[XB_XGEN(b.x)], 1u);
            asm volatile("s_waitcnt vmcnt(0)" ::: "memory");
        } else {
            XB_SPIN(xb_ld(&bar[XB_XGEN(b.x)]) == gen, bar);
            __builtin_amdgcn_fence(__ATOMIC_ACQUIRE, "agent");
            asm volatile("s_waitcnt vmcnt(0)" ::: "memory");
        }
    }
    __syncthreads();
}
DI void seam(unsigned char* shm) {
    CArgs* kp = (CArgs*)__builtin_amdgcn_kernarg_segment_ptr(); asm volatile("" : "+s"(kp));
    XcdBarrier b; b.bar = (unsigned*)(kp->ws + W_BAR); b.x = xb_xcc_id(); b.st = (volatile LAS unsigned*)(LAS unsigned char*)(shm + LDS_CTL + 16);
    xcd_barrier(b);
}

#ifndef FUSE_PRE
#define FUSE_PRE 1
#endif
constexpr int NPH = 9;
template <int ph>
DI void run_phase(unsigned char* shm) {
    LAS unsigned char* lds = (LAS unsigned char*)shm;
    const int G = (int)gridDim.x, bid = (int)blockIdx.x;
    constexpr int layer = ph >= 4 ? 1 : 0;
    int tid = threadIdx.x; asm volatile("" : "+v"(tid));
    CArgs* kp = (CArgs*)__builtin_amdgcn_kernarg_segment_ptr(); asm volatile("" : "+s"(kp)); CArgs& a = *kp;
    unsigned char* ws = a.ws;
    if constexpr (ph == 0 || ph == 4) { if (ph == 0) phase_prep(tid, a, shm);
        phase_norm(tid, a, layer, ph ? a.out : a.in[I_XP], ph ? a.out + O_YS : a.in[I_XS], shm, !(ph == 4 && G == 256 && FUSE_PRE)); }
    else if constexpr (ph == 2 || ph == 6) phase_mixers(a, layer, shm);
    else if constexpr (ph == 8) phase_final_norm(tid, a);
    else {
        constexpr int nsub = ph == 1 ? 2 : 1;
        const bool gate5 = ph == 5 && G == 256 && FUSE_PRE;
        unsigned* depX = (unsigned*)(ws + W_CTL) + 672;
        if (gate5 && bid >= G - 16) { norm_sample_rows(tid, a, 1, a.out + O_YS); task_done(tid, depX); }
        for (int sub = 0; sub < nsub; ++sub) {
            pg8::Gemm g; pg8::Epi E; int c = bid; g.ready = nullptr; g.need = 0; g.gate_pm = -1;
            E.O = (bf16_t*)(ws + W_PROJ); E.SY = (const bf16_t*)(ws + W_SY); E.PROJ = (const bf16_t*)(ws + W_PROJ); E.out = a.out; E.src = a.out;
            E.xbuf = (float*)(ws + (ph == 3 ? W_XB2 : W_XB)); E.pcnt = (unsigned*)(ws + W_PCNT) + (ph == 3 ? 1024 : 0); E.nw = ph == 3 ? a.in[I_NW] + 1024 : a.in[I_FNW]; E.XNo = (bf16_t*)(ws + W_XN);
            if (ph == 1 || ph == 5) {
                if (sub == 0) { g.A = (const bf16_t*)(ws + W_XN); g.Bt = (const bf16_t*)(ws + W_WINT) + (size_t)layer * NPROJ * 1024; g.M = MPAD; g.N = NPROJ; g.K = 1024; E.mode = 0; if (gate5) { g.ready = depX; g.need = 16u; g.gate_pm = 64; } }
                else { g.A = (const bf16_t*)(ws + W_MEMB); g.Bt = (const bf16_t*)(ws + W_WMEMT); g.M = 2048; g.N = 1024; g.K = 1024; E.mode = 1; c = G - 1 - bid; }
            } else { g.A = (const bf16_t*)(ws + W_MIX); g.Bt = (const bf16_t*)(ws + W_WOUTT) + (size_t)layer * 1024 * 1024; g.M = MP; g.N = 1024; g.K = 1024; E.mode = G == 256 ? (ph == 7 ? 4 : (FUSE_PRE ? 5 : 3)) : 3; E.src = layer ? a.out : a.in[I_XP]; }
            pg8::StaticOrder S; S.init(g.M, g.N, G, c);
            pg8::gemm_phase(tid, lds, g, S, E);
        }
        if (ph == 1) { const int blo = G == 256 ? 142 : 0, bhi = G == 256 ? 224 : G;
            if (bid >= blo && bid < bhi)
#pragma unroll 1
            for (int j = bid - blo; j < 272; j += bhi - blo) prep_tile(tid, a, j < 256 ? 1920 + j : 2448 + (j - 256), (float*)shm);
        }
        if (ph == 3 || ph == 7) outproj_sample(tid, a, layer, layer ? a.out + O_YS : a.in[I_XS]);
        if (G == 256 && ph == 7) {
            unsigned* depS = (unsigned*)(ws + W_CTL) + (ph == 3 ? 656 : 640);
            if (bid < 64) task_done(tid, depS);
            else if (bid < 192) {
                if (tid == 0) { unsigned sp = 0; while (__hip_atomic_load(depS, __ATOMIC_RELAXED, __HIP_MEMORY_SCOPE_AGENT) < 64u && ++sp < (1u << 22)) __builtin_amdgcn_s_sleep(2); __threadfence(); }
                __syncthreads();
                if (tid < 64) { float* p = a.out + O_YS + (size_t)(bid - 64) * 1024; const float* nw = ph == 3 ? a.in[I_NW] + 1024 : a.in[I_FNW]; f32x4 x[4]; float ss = 0.f;
#pragma unroll
                    for (int i = 0; i < 4; ++i) { x[i] = *(const f32x4*)(p + 256 * i + 4 * tid); ss += x[i][0] * x[i][0] + x[i][1] * x[i][1] + x[i][2] * x[i][2] + x[i][3] * x[i][3]; }
                    ss = wave_sum(ss); const float rstd = rsqrtf(ss * (1.0f / 1024.0f) + EPS);
#pragma unroll
                    for (int i = 0; i < 4; ++i) { const f32x4 w = *(const f32x4*)(nw + 256 * i + 4 * tid); const f32x4 y = x[i] * rstd * w;
                        if (ph == 7) *(f32x4*)(p + 256 * i + 4 * tid) = y;
                        else { u32x2 o; o.x = pk2(y[0], y[1]); o.y = pk2(y[2], y[3]); *(u32x2*)((bf16_t*)(ws + W_XN) + (size_t)(MP + bid - 64) * 1024 + 256 * i + 4 * tid) = o; } } }
            }
        }
    }
}

__global__ __launch_bounds__(512, 2) void mk_fwd(Args a_) {
    extern __shared__ __attribute__((aligned(16))) unsigned char shm[];
    cg::grid_group grid = cg::this_grid();
    const int lo = a_.ph_lo, hi = a_.ph_hi;
    if (hi - lo > 1) {
        if (threadIdx.x < 4) ((volatile LAS unsigned*)(LAS unsigned char*)(shm + LDS_CTL + 16))[threadIdx.x] = 0u;
        __syncthreads();
        CArgs* kp = (CArgs*)__builtin_amdgcn_kernarg_segment_ptr();
        (void)xcd_barrier_post((unsigned*)(kp->ws + W_BAR), (volatile LAS unsigned*)(LAS unsigned char*)(shm + LDS_CTL + 16));
    }
    if (hi > 1000) grid.sync();
#define RUN_PHASE(P) if (P >= lo && P < hi) { run_phase<P>(shm); if (P + 1 < hi) seam(shm); }
    const bool fusedn = gridDim.x == 256 && lo == 0 && hi == NPH;
    RUN_PHASE(0) RUN_PHASE(1) RUN_PHASE(2)
    RUN_PHASE(3)
    if (!(fusedn && FUSE_PRE)) { RUN_PHASE(4) }
    RUN_PHASE(5) RUN_PHASE(6)
    if (fusedn) { run_phase<7>(shm); } else { RUN_PHASE(7) RUN_PHASE(8) }
#undef RUN_PHASE
}

#ifndef N_LAUNCH_PER_PHASE
#define N_LAUNCH_PER_PHASE 0
#endif
extern "C" void kernel_launch(void* const* d_in, const int* in_sizes, int n_in, void* d_out, int out_size, void* d_ws, size_t ws_size, hipStream_t stream) {
    static int grid = 0;
    if (grid == 0) {
        if (n_in != 30 || ws_size < W_END) { fprintf(stderr, "kernel_launch: unexpected n_in %d / ws %zu (need %zu)\n", n_in, ws_size, (size_t)W_END); grid = -1; return; }
        int dev = 0, cus = 0, per_cu = 0;
        hipGetDevice(&dev); hipDeviceGetAttribute(&cus, hipDeviceAttributeMultiprocessorCount, dev);
        if (hipFuncSetAttribute((const void*)mk_fwd, hipFuncAttributeMaxDynamicSharedMemorySize, LDS_BYTES) != hipSuccess) { fprintf(stderr, "kernel_launch: hipFuncSetAttribute failed\n"); grid = -1; return; }
        if (hipOccupancyMaxActiveBlocksPerMultiprocessor(&per_cu, (const void*)mk_fwd, 512, LDS_BYTES) != hipSuccess || per_cu < 1) { fprintf(stderr, "kernel_launch: occupancy query says %d\n", per_cu); per_cu = 1; }
        (void)hipGetLastError();
        grid = cus * per_cu;
    }
    if (grid < 0) return;
    if (hipMemsetAsync(d_ws, 0, W_WINT, stream) != hipSuccess) { fprintf(stderr, "kernel_launch: hipMemsetAsync failed\n"); return; }
    Args a{};
    for (int i = 0; i < 30; ++i) a.in[i] = (const float*)d_in[i];
    a.out = (float*)d_out; a.ws = (unsigned char*)d_ws;
#if N_LAUNCH_PER_PHASE
    for (int ph = 0; ph < NPH; ++ph) { if (grid == 256 && (ph == 4 || ph == 8)) continue; a.ph_lo = ph; a.ph_hi = ph + 1; hipLaunchKernelGGL(mk_fwd, dim3(grid), dim3(512), LDS_BYTES, stream, a); }
#else
    a.ph_lo = 0; a.ph_hi = NPH;
    void* args[] = {&a};
    hipError_t e = hipLaunchCooperativeKernel((const void*)mk_fwd, dim3(grid), dim3(512), args, LDS_BYTES, stream);
    if (e != hipSuccess) fprintf(stderr, "cooperative launch failed: %s (grid %d)\n", hipGetErrorString(e), grid);
#endif
}
```
